# Optimizing an MI355X kernel written in HIP

```python
import jax, jax.numpy as jnp
from jax import lax
import numpy as np

D_MODEL = 1024
BATCH = 16
SEQ = 256
DEPTH = 4
DEC_BATCH = 2
DEC_SEQ = 1024
PAST_LEN = 512

GRID_W = 64
HEAD_DIM = 64
BRANCH_W = D_MODEL // 2
GLA_HEADS = 4
GLA_DV = BRANCH_W // GLA_HEADS
GLA_DK = GLA_DV // 2
GLA_LOWRANK = 16
GLA_TAU = 16.0
GLA_CHUNK = 32
SWA_Q_HEADS = BRANCH_W // HEAD_DIM
SWA_KV_HEADS = 2
SWA_GROUP = SWA_Q_HEADS // SWA_KV_HEADS
SWA_WINDOW = 128
SWA_BLOCK = 128
NA_HEADS = BRANCH_W // HEAD_DIM
NA_ROWS = 8
NA_COLS = 16
MLP_HIDDEN = 4 * D_MODEL
ROPE_BASE = 10000.0
EPS = 1e-6
Q_BLOCK = 128

SPLIT_SIZES = (
    GLA_HEADS * GLA_DK, GLA_HEADS * GLA_DK, GLA_HEADS * GLA_DV, GLA_HEADS * GLA_DV,
    GLA_LOWRANK, GLA_LOWRANK,
    SWA_Q_HEADS * HEAD_DIM, SWA_KV_HEADS * HEAD_DIM, SWA_KV_HEADS * HEAD_DIM,
    NA_HEADS * HEAD_DIM, NA_HEADS * HEAD_DIM, NA_HEADS * HEAD_DIM,
    D_MODEL, D_MODEL, D_MODEL,
)
IN_W = sum(SPLIT_SIZES)

kernel_name = "hybrid_prefix_diffusion_trunk_step"


def rms_norm(x, g):
    xf = x.astype(jnp.float32)
    y = xf * lax.rsqrt(jnp.mean(xf * xf, axis=-1, keepdims=True) + EPS)
    return (y * g.astype(jnp.float32)).astype(x.dtype)


def split_proj(z):
    idx = np.cumsum(np.array(SPLIT_SIZES))[:-1].tolist()
    return jnp.split(z, idx, axis=-1)


def axial_rope(x):
    n = x.shape[1]
    t = jnp.arange(n)
    row = (t // GRID_W).astype(jnp.float32)
    col = (t % GRID_W).astype(jnp.float32)
    half = x.shape[-1] // 2
    nf = half // 2
    inv_freq = ROPE_BASE ** (-jnp.arange(nf, dtype=jnp.float32) / nf)

    def rot(xh, pos):
        ang = pos[:, None] * inv_freq[None, :]
        cos = jnp.cos(ang)[None, :, None, :].astype(x.dtype)
        sin = jnp.sin(ang)[None, :, None, :].astype(x.dtype)
        x1, x2 = xh[..., :nf], xh[..., nf:]
        return jnp.concatenate([x1 * cos - x2 * sin, x1 * sin + x2 * cos], axis=-1)

    return jnp.concatenate([rot(x[..., :half], row), rot(x[..., half:], col)], axis=-1)


def softmax_attend(q, parts, sink):
    scale = q.shape[-1] ** -0.5
    scores = []
    for k, _, bias in parts:
        s = jnp.einsum('bqhgd,bkhd->bhgqk', q, k).astype(jnp.float32) * scale
        if bias is not None:
            s = s + bias
        scores.append(s)
    if sink is not None:
        scores.append(jnp.broadcast_to(sink.astype(jnp.float32)[None, :, :, None, None], scores[0].shape[:-1] + (1,)))
    p = jax.nn.softmax(jnp.concatenate(scores, axis=-1), axis=-1)
    out = None
    off = 0
    for k, v, _ in parts:
        tk = k.shape[1]
        o = jnp.einsum('bhgqk,bkhd->bqhgd', p[..., off:off + tk].astype(v.dtype), v)
        out = o if out is None else out + o
        off += tk
    return out


def dense_ctx_attention(q, k, v, sink):
    b, s = q.shape[:2]
    nb = s // Q_BLOCK
    qb = q.reshape((b, nb, Q_BLOCK) + q.shape[2:]).swapaxes(0, 1)
    out = lax.map(lambda qi: softmax_attend(qi, [(k, v, None)], sink), qb)
    return out.swapaxes(0, 1).reshape(q.shape)


def windowed_attention(q, k, v, k_ctx, v_ctx, sink):
    b, n = q.shape[:2]
    nb = n // SWA_BLOCK
    span = SWA_BLOCK + 2 * SWA_WINDOW
    pad = ((0, 0), (SWA_WINDOW, SWA_WINDOW), (0, 0), (0, 0))
    kp = jnp.pad(k, pad)
    vp = jnp.pad(v, pad)
    i = jnp.arange(SWA_BLOCK)[:, None]
    j = jnp.arange(span)[None, :]
    rel = j - i
    band = (rel >= 0) & (rel <= 2 * SWA_WINDOW)

    def blk(args):
        qi, nidx = args
        start = nidx * SWA_BLOCK
        ki = lax.dynamic_slice_in_dim(kp, start, span, axis=1)
        vi = lax.dynamic_slice_in_dim(vp, start, span, axis=1)
        kpos = start - SWA_WINDOW + j
        valid = band & (kpos >= 0) & (kpos < n)
        bias = jnp.where(valid, 0.0, -jnp.inf).astype(jnp.float32)
        return softmax_attend(qi, [(ki, vi, bias), (k_ctx, v_ctx, None)], sink)

    qb = q.reshape((b, nb, SWA_BLOCK) + q.shape[2:]).swapaxes(0, 1)
    out = lax.map(blk, (qb, jnp.arange(nb)))
    return out.swapaxes(0, 1).reshape(q.shape)


def neighbourhood_attention(q, k, v, k_ctx, v_ctx, rpb):
    b, n, h, dh = q.shape
    rows = n // GRID_W
    wr = min(NA_ROWS, rows)
    qg = q.reshape(b, rows, GRID_W, h, 1, dh).swapaxes(0, 1)
    kg = k.reshape(b, rows, GRID_W, h, dh)
    vg = v.reshape(b, rows, GRID_W, h, dh)
    cq = jnp.arange(GRID_W)[:, None]
    ck = jnp.arange(GRID_W)[None, :]
    cs = jnp.clip(cq - NA_COLS // 2, 0, GRID_W - NA_COLS)
    col_ok = (ck >= cs) & (ck < cs + NA_COLS)
    dc_idx = jnp.clip(ck - cq + NA_COLS - 1, 0, 2 * NA_COLS - 2)

    def row_blk(args):
        qi, r = args
        rs = jnp.clip(r - NA_ROWS // 2, 0, rows - wr)
        ki = lax.dynamic_slice_in_dim(kg, rs, wr, axis=1).reshape(b, wr * GRID_W, h, dh)
        vi = lax.dynamic_slice_in_dim(vg, rs, wr, axis=1).reshape(b, wr * GRID_W, h, dh)
        dr_idx = rs + jnp.arange(wr) - r + NA_ROWS - 1
        bias = rpb[:, dr_idx[None, :, None], dc_idx[:, None, :]].astype(jnp.float32)
        bias = jnp.where(col_ok[:, None, :], bias, -jnp.inf).reshape(h, GRID_W, wr * GRID_W)
        return softmax_attend(qi, [(ki, vi, bias[:, None]), (k_ctx, v_ctx, None)], None)

    out = lax.map(row_blk, (qg, jnp.arange(rows)))
    return out.swapaxes(0, 1).reshape(b, n, h, dh)


def gla_chunked(q, k, v, log_a, s0):
    b, n, h, dk = q.shape
    dv = v.shape[-1]
    c = GLA_CHUNK
    nc = n // c
    f32 = jnp.float32
    qc = q.astype(f32).reshape(b, nc, c, h, dk)
    kc = k.astype(f32).reshape(b, nc, c, h, dk)
    vc = v.astype(f32).reshape(b, nc, c, h, dv)
    cum = jnp.cumsum(log_a.astype(f32).reshape(b, nc, c, h, dk), axis=2)
    tri = jnp.tril(jnp.ones((c, c), dtype=bool))
    diff = cum[:, :, :, None] - cum[:, :, None, :]
    decay = jnp.exp(jnp.where(tri[None, None, :, :, None, None], diff, -jnp.inf))
    attn = jnp.einsum('bnthd,bnshd,bntshd->bnhts', qc, kc, decay)
    o_intra = jnp.einsum('bnhts,bnshv->bnthv', attn, vc)
    last = cum[:, :, -1]
    q_in = qc * jnp.exp(cum)
    k_in = kc * jnp.exp(last[:, :, None] - cum)
    a_last = jnp.exp(last)

    def step(state, xs):
        qi, ki, vi, ai = xs
        o = jnp.einsum('bthk,bhkv->bthv', qi, state)
        state = state * ai[..., None] + jnp.einsum('bthk,bthv->bhkv', ki, vi)
        return state, o

    xs = (q_in.swapaxes(0, 1), k_in.swapaxes(0, 1), vc.swapaxes(0, 1), a_last.swapaxes(0, 1))
    s_fin, o_inter = lax.scan(step, s0.astype(f32), xs)
    o = o_intra + o_inter.swapaxes(0, 1)
    return o.reshape(b, n, h, dv).astype(v.dtype), s_fin


def mixer(h, l, w, ctx):
    b, n, _ = h.shape
    (aq, ak, av, ar, alf, alb, bq, bk, bv, cq, ck, cv, ga, gb, gc) = split_proj(h @ w['w_in'][l])

    qa = aq.reshape(b, n, GLA_HEADS, GLA_DK) * (GLA_DK ** -0.5)
    ka = ak.reshape(b, n, GLA_HEADS, GLA_DK)
    va = av.reshape(b, n, GLA_HEADS, GLA_DV)
    log_f = (jax.nn.log_sigmoid((alf @ w['w_a2_f'][l] + w['b_a_f'][l]).astype(jnp.float32)) / GLA_TAU).reshape(b, n, GLA_HEADS, GLA_DK)
    log_b = (jax.nn.log_sigmoid((alb @ w['w_a2_b'][l] + w['b_a_b'][l]).astype(jnp.float32)) / GLA_TAU).reshape(b, n, GLA_HEADS, GLA_DK)
    if ctx is None:
        s0 = jnp.zeros((b, 2, GLA_HEADS, GLA_DK, GLA_DV), jnp.float32)
    else:
        s0 = ctx[0]
    o_f, s_f = gla_chunked(qa, ka, va, log_f, s0[:, 0])
    o_b, s_b = gla_chunked(jnp.flip(qa, 1), jnp.flip(ka, 1), jnp.flip(va, 1), jnp.flip(log_b, 1), s0[:, 1])
    o_a = rms_norm(o_f + jnp.flip(o_b, 1), w['gla_onorm'][l]).reshape(b, n, GLA_HEADS * GLA_DV) * jax.nn.silu(ar)

    qb = rms_norm(bq.reshape(b, n, SWA_Q_HEADS, HEAD_DIM), w['qn_swa'][l])
    kb = rms_norm(bk.reshape(b, n, SWA_KV_HEADS, HEAD_DIM), w['kn_swa'][l])
    vb = bv.reshape(b, n, SWA_KV_HEADS, HEAD_DIM)
    sink = w['sink_swa'][l].reshape(SWA_KV_HEADS, SWA_GROUP)
    if ctx is None:
        o_b_attn = dense_ctx_attention(qb.reshape(b, n, SWA_KV_HEADS, SWA_GROUP, HEAD_DIM), kb, vb, sink)
    else:
        qr = axial_rope(qb).reshape(b, n, SWA_KV_HEADS, SWA_GROUP, HEAD_DIM)
        o_b_attn = windowed_attention(qr, axial_rope(kb), vb, ctx[1], ctx[2], sink)

    qn = rms_norm(cq.reshape(b, n, NA_HEADS, HEAD_DIM), w['qn_na'][l])
    kn = rms_norm(ck.reshape(b, n, NA_HEADS, HEAD_DIM), w['kn_na'][l])
    vn = cv.reshape(b, n, NA_HEADS, HEAD_DIM)
    if ctx is None:
        o_c = dense_ctx_attention(qn[:, :, :, None, :], kn, vn, None)[:, :, :, 0]
    else:
        o_c = neighbourhood_attention(qn, kn, vn, ctx[3], ctx[4], w['rpb_na'][l])

    ya = o_a @ w['w_pa'][l]
    yb = o_b_attn.reshape(b, n, SWA_Q_HEADS * HEAD_DIM) @ w['w_pb'][l]
    yc = o_c.reshape(b, n, NA_HEADS * HEAD_DIM) @ w['w_pc'][l]
    merged = jax.nn.sigmoid(ga) * ya + jax.nn.sigmoid(gb) * yb + jax.nn.sigmoid(gc) * yc
    out = merged @ w['w_o'][l]
    if ctx is None:
        return out, (jnp.stack([s_f, s_b], axis=1), kb, vb, kn, vn)
    return out, None


def trunk_layer(x, cond, l, w, ctx):
    mod = jax.nn.silu(cond) @ w['w_mod'][l] + w['b_mod'][l]
    sh1, sc1, g1, sh2, sc2, g2 = jnp.split(mod[:, None, :], 6, axis=-1)
    h = rms_norm(x, w['norm1'][l]) * (1 + sc1) + sh1
    mix, new_ctx = mixer(h, l, w, ctx)
    x = x + g1 * mix
    h = rms_norm(x, w['norm2'][l]) * (1 + sc2) + sh2
    x = x + g2 * (jnp.square(jax.nn.relu(h @ w['w_fc1'][l])) @ w['w_fc2'][l])
    return x, new_ctx


def setup_inputs(seed: int = 0) -> dict:
    key = jax.random.key(seed)
    ks = jax.random.split(key, 32)

    def nrm(k, shape, scale):
        return jax.random.normal(k, shape, jnp.float32) * scale

    d = D_MODEL
    return {
        "x_prompt": nrm(ks[0], (BATCH, SEQ, d), 1.0),
        "x_sample": nrm(ks[1], (DEC_BATCH, DEC_SEQ, d), 1.0),
        "state_gla": nrm(ks[2], (DEC_BATCH, DEPTH, 2, GLA_HEADS, GLA_DK, GLA_DV), 0.5),
        "cache_swa_k": nrm(ks[3], (DEC_BATCH, DEPTH, PAST_LEN, SWA_KV_HEADS, HEAD_DIM), 1.0),
        "cache_swa_v": nrm(ks[4], (DEC_BATCH, DEPTH, PAST_LEN, SWA_KV_HEADS, HEAD_DIM), 1.0),
        "cache_na_k": nrm(ks[5], (DEC_BATCH, DEPTH, PAST_LEN, NA_HEADS, HEAD_DIM), 1.0),
        "cache_na_v": nrm(ks[6], (DEC_BATCH, DEPTH, PAST_LEN, NA_HEADS, HEAD_DIM), 1.0),
        "c": nrm(ks[7], (DEC_BATCH, d), 1.0),
        "c_ctx": nrm(ks[8], (d,), 1.0),
        "w_mod": nrm(ks[9], (DEPTH, d, 6 * d), d ** -0.5),
        "b_mod": nrm(ks[10], (DEPTH, 6 * d), 0.02),
        "norm1": 1.0 + nrm(ks[11], (DEPTH, d), 0.05),
        "norm2": 1.0 + nrm(ks[12], (DEPTH, d), 0.05),
        "w_in": nrm(ks[13], (DEPTH, d, IN_W), d ** -0.5),
        "w_a2_f": nrm(ks[14], (DEPTH, GLA_LOWRANK, GLA_HEADS * GLA_DK), GLA_LOWRANK ** -0.5),
        "b_a_f": nrm(ks[15], (DEPTH, GLA_HEADS * GLA_DK), 0.1),
        "w_a2_b": nrm(ks[16], (DEPTH, GLA_LOWRANK, GLA_HEADS * GLA_DK), GLA_LOWRANK ** -0.5),
        "b_a_b": nrm(ks[17], (DEPTH, GLA_HEADS * GLA_DK), 0.1),
        "gla_onorm": 1.0 + nrm(ks[18], (DEPTH, GLA_DV), 0.05),
        "qn_swa": 1.0 + nrm(ks[19], (DEPTH, HEAD_DIM), 0.05),
        "kn_swa": 1.0 + nrm(ks[20], (DEPTH, HEAD_DIM), 0.05),
        "sink_swa": nrm(ks[21], (DEPTH, SWA_Q_HEADS), 0.5),
        "qn_na": 1.0 + nrm(ks[22], (DEPTH, HEAD_DIM), 0.05),
        "kn_na": 1.0 + nrm(ks[23], (DEPTH, HEAD_DIM), 0.05),
        "rpb_na": nrm(ks[24], (DEPTH, NA_HEADS, 2 * NA_ROWS - 1, 2 * NA_COLS - 1), 0.5),
        "w_pa": nrm(ks[25], (DEPTH, GLA_HEADS * GLA_DV, d), (GLA_HEADS * GLA_DV) ** -0.5),
        "w_pb": nrm(ks[26], (DEPTH, SWA_Q_HEADS * HEAD_DIM, d), (SWA_Q_HEADS * HEAD_DIM) ** -0.5),
        "w_pc": nrm(ks[27], (DEPTH, NA_HEADS * HEAD_DIM, d), (NA_HEADS * HEAD_DIM) ** -0.5),
        "w_o": nrm(ks[28], (DEPTH, d, d), d ** -0.5),
        "w_fc1": nrm(ks[29], (DEPTH, d, MLP_HIDDEN), d ** -0.5),
        "w_fc2": nrm(ks[30], (DEPTH, MLP_HIDDEN, d), MLP_HIDDEN ** -0.5),
    }


def reference(x_prompt, x_sample, state_gla, cache_swa_k, cache_swa_v, cache_na_k, cache_na_v, c,
              c_ctx, w_mod, b_mod, norm1, norm2, w_in, w_a2_f, b_a_f, w_a2_b, b_a_b, gla_onorm,
              qn_swa, kn_swa, sink_swa, qn_na, kn_na, rpb_na, w_pa, w_pb, w_pc, w_o, w_fc1, w_fc2):
    w = dict(w_mod=w_mod, b_mod=b_mod, norm1=norm1, norm2=norm2, w_in=w_in, w_a2_f=w_a2_f, b_a_f=b_a_f,
             w_a2_b=w_a2_b, b_a_b=b_a_b, gla_onorm=gla_onorm, qn_swa=qn_swa, kn_swa=kn_swa,
             sink_swa=sink_swa, qn_na=qn_na, kn_na=kn_na, rpb_na=rpb_na, w_pa=w_pa, w_pb=w_pb,
             w_pc=w_pc, w_o=w_o, w_fc1=w_fc1, w_fc2=w_fc2)

    xp = x_prompt
    st_l, bk_l, bv_l, nk_l, nv_l = [], [], [], [], []
    for l in range(DEPTH):
        xp, (st, bk, bv, nk, nv) = trunk_layer(xp, c_ctx[None, :], l, w, None)
        st_l.append(st)
        bk_l.append(bk)
        bv_l.append(bv)
        nk_l.append(nk)
        nv_l.append(nv)

    xs = x_sample
    for l in range(DEPTH):
        ctx = (state_gla[:, l], cache_swa_k[:, l], cache_swa_v[:, l], cache_na_k[:, l], cache_na_v[:, l])
        xs, _ = trunk_layer(xs, c, l, w, ctx)

    new_state_gla = jnp.stack(st_l, axis=1)
    new_swa_k = jnp.stack(bk_l, axis=1)
    new_swa_v = jnp.stack(bv_l, axis=1)
    new_na_k = jnp.stack(nk_l, axis=1)
    new_na_v = jnp.stack(nv_l, axis=1)
    return (xp, xs, new_state_gla, new_swa_k, new_swa_v, new_na_k, new_na_v)
```

```cpp
#include <hip/hip_runtime.h>
#include <hip/hip_bf16.h>
#include <hip/hip_cooperative_groups.h>
#include <cstdio>
#include <cstdint>
namespace cg = cooperative_groups;

#ifndef MK_ONE_LAUNCH
#define MK_ONE_LAUNCH 1
#endif

typedef unsigned short u16;
using bf16x8 = __attribute__((ext_vector_type(8))) short;
using s16x4 = __attribute__((ext_vector_type(4))) short;
using u32x4 = __attribute__((ext_vector_type(4))) unsigned;
using u32x2 = __attribute__((ext_vector_type(2))) unsigned;
using f32x4 = __attribute__((ext_vector_type(4))) float;
using f32x16 = __attribute__((ext_vector_type(16))) float;
#define DI __device__ __forceinline__

constexpr int DM = 1024, NTOK = 6144, NCTX = 4096, ZW = 7040, ATTW = 1536, HID = 4096;
constexpr int C_AQ = 0, C_AK = 256, C_AV = 512, C_AR = 1024, C_ALF = 1536, C_BQ = 1664, C_BK = 2176, C_BV = 2304,
              C_CQ = 2432, C_CK = 2944, C_CV = 3456, C_GA = 3968;
constexpr size_t O_ST = 6291456, O_SWK = 10485760, O_SWV = 12582912, O_NAK = 14680064, O_NAV = 23068672;

constexpr size_t WS_BAR = 0;
constexpr size_t WS_CTR = 16384;
constexpr size_t WS_MOD = 65536;
constexpr size_t WS_ROPE = WS_MOD + 294912;
constexpr size_t WS_WIN = 1u << 20;
constexpr size_t WS_WP = WS_WIN + (size_t)4 * ZW * 1024 * 2;
constexpr size_t WS_WO = WS_WP + (size_t)4 * 3 * 1024 * 512 * 2;
constexpr size_t WS_W1 = WS_WO + (size_t)4 * 1024 * 1024 * 2;
constexpr size_t WS_W2 = WS_W1 + (size_t)4 * 4096 * 1024 * 2;
constexpr size_t WS_H = WS_W2 + (size_t)4 * 4096 * 1024 * 2;
constexpr size_t WS_ZB = WS_H + (size_t)NTOK * 1024 * 2;
constexpr size_t WS_OF = WS_ZB + (size_t)NTOK * ZW * 2;
constexpr size_t WS_OB = WS_OF + (size_t)NTOK * 512 * 4;
constexpr size_t WS_ATT = WS_OB + (size_t)NTOK * 512 * 4;
constexpr size_t WS_MRG = WS_ATT + (size_t)NTOK * ATTW * 2;
constexpr size_t WS_U = WS_MRG + (size_t)NTOK * 1024 * 2;
constexpr size_t WS_DS = WS_U;
constexpr size_t WS_SB = WS_U + (size_t)NTOK * HID * 2;
constexpr size_t WS_QIN = WS_SB + (size_t)1536 * 8192 * 2;
constexpr size_t WS_AV = WS_QIN + (size_t)1536 * 2048 * 2;
constexpr size_t WS_KCS = WS_AV + (size_t)1536 * 64 * 4;
constexpr size_t WS_VCS = WS_KCS + (size_t)2 * 4 * 2 * 512 * 64 * 2;
constexpr size_t WS_KCN = WS_VCS + (size_t)2 * 4 * 2 * 512 * 64 * 2;
constexpr size_t WS_VCN = WS_KCN + (size_t)2 * 4 * 8 * 512 * 64 * 2;
constexpr size_t WS_VTS = WS_VCN + (size_t)2 * 4 * 8 * 512 * 64 * 2;
constexpr size_t WS_VTN = WS_VTS + (size_t)128 * NTOK * 2;
constexpr size_t WS_END = WS_VTN + (size_t)512 * NTOK * 2;

constexpr int LDS_BYTES = 73728;
constexpr int NSPL = 10;
constexpr int NSTEPS = 1 + NSPL * 4;

struct Params {
  const float* in[31];
  float* out;
  unsigned char* ws;
  int ph_lo, ph_hi, one, pad;
};

typedef __bf16 bf16x2_t __attribute__((ext_vector_type(2)));
typedef float f32x2_t __attribute__((ext_vector_type(2)));
DI u16 f2bf(float x) { return __builtin_bit_cast(u16, (__bf16)x); }
DI float bf2f(u16 v) { return __uint_as_float(((unsigned)v) << 16); }
DI unsigned pack2(float a, float b) { f32x2_t v = {a, b}; return __builtin_bit_cast(unsigned, __builtin_convertvector(v, bf16x2_t)); }
DI float bflo(unsigned u) { return __uint_as_float(u << 16); }
DI float bfhi(unsigned u) { return __uint_as_float(u & 0xffff0000u); }
DI int otid() { int t = threadIdx.x; asm volatile("" : "+v"(t)); return t; }
DI float sigmoidf(float x) { return 1.f / (1.f + __expf(-x)); }
DI float siluf(float x) { return x / (1.f + __expf(-x)); }

#define XB_TMO 128
#define XB_XCNT(j) (256 + 64 * (j))
#define XB_XSUB(j) (1280 + 64 * (j))
#define XB_XGEN(j) (2304 + 64 * (j))
#define XB_TOP 3328
#define XB_TOPGEN 3392
#define XCD_BAR_WORDS 3456
#define XB_SPIN_CAP (1u << 20)
DI unsigned xb_ld(unsigned* p) { return __hip_atomic_load(p, __ATOMIC_RELAXED, __HIP_MEMORY_SCOPE_AGENT); }
DI unsigned xb_add(unsigned* p, unsigned v) { return __hip_atomic_fetch_add(p, v, __ATOMIC_RELAXED, __HIP_MEMORY_SCOPE_AGENT); }
DI unsigned xb_xcc_id() { return (unsigned)__builtin_amdgcn_s_getreg((3 << 11) | 20) & 0xFu; }
#define XB_SPIN(cond, bar) do { unsigned _sp = 0; while (cond) { __builtin_amdgcn_s_sleep(1); \
    if ((++_sp & 255u) == 0u) { if (xb_ld(&(bar)[XB_TMO])) break; if (_sp > XB_SPIN_CAP) { atomicAdd(&(bar)[XB_TMO], 1u); break; } } } } while (0)

DI void xcd_barrier_complete(unsigned* bar, unsigned x, unsigned& nloc, unsigned& nx) {
  const unsigned G = gridDim.x;
  unsigned sum, cnt, mine, sp = 0u;
  for (;;) {
    sum = 0u; cnt = 0u; mine = 0u;
#pragma unroll
    for (unsigned j = 0; j < 16; ++j) { const unsigned c = xb_ld(&bar[XB_XCNT(j)]); sum += c; cnt += (c > 0u) ? 1u : 0u; mine = (j == x) ? c : mine; }
    if (sum == G) break;
    __builtin_amdgcn_s_sleep(1);
    if ((++sp & 255u) == 0u) { if (xb_ld(&bar[XB_TMO])) break; if (sp > XB_SPIN_CAP) { atomicAdd(&bar[XB_TMO], 1u); break; } }
  }
  nloc = mine > 0u ? mine : 1u; nx = cnt > 0u ? cnt : 1u;
}
DI void xcd_barrier(unsigned* bar, unsigned x, volatile unsigned* st) {
  asm volatile("s_waitcnt vmcnt(0)" ::: "memory");
  __syncthreads();
  if (threadIdx.x == 0) {
    __builtin_amdgcn_s_waitcnt(0);
    unsigned nloc = st[0], nx = st[1];
    if (nloc == 0u) { xcd_barrier_complete(bar, x, nloc, nx); st[0] = nloc; st[1] = nx; }
    const unsigned old = xb_add(&bar[XB_XSUB(x)], 1u);
    const unsigned gen = old / nloc;
    if (old + 1u == (gen + 1u) * nloc) {
      __builtin_amdgcn_fence(__ATOMIC_RELEASE, "agent");
      asm volatile("s_waitcnt vmcnt(0)" ::: "memory");
      const unsigned og = xb_add(&bar[XB_TOP], 1u);
      const unsigned tg = og / nx;
      if (og + 1u == (tg + 1u) * nx) xb_add(&bar[XB_TOPGEN], 1u);
      else XB_SPIN(xb_ld(&bar[XB_TOPGEN]) == tg, bar);
      __builtin_amdgcn_fence(__ATOMIC_ACQUIRE, "agent");
      xb_add(&bar[XB_XGEN(x)], 1u);
      asm volatile("s_waitcnt vmcnt(0)" ::: "memory");
    } else {
      XB_SPIN(xb_ld(&bar[XB_XGEN(x)]) == gen, bar);
      __builtin_amdgcn_fence(__ATOMIC_ACQUIRE, "agent");
      asm volatile("s_waitcnt vmcnt(0)" ::: "memory");
    }
  }
  __syncthreads();
}

struct Ctx {
  const float* const* in;
  float* out;
  unsigned char* ws;
  unsigned char* lds;
};
DI const float* xrow_src(const Ctx& c, int layer, int t) {
  if (layer == 0) return (t < NCTX) ? (c.in[0] + (size_t)t * DM) : (c.in[1] + (size_t)(t - NCTX) * DM);
  return c.out + (size_t)t * DM;
}
DI int cond_of(int t) { return t < NCTX ? 0 : 1 + ((t - NCTX) >> 10); }

DI void tr_tile(const float* __restrict__ src, int N, int k0, int n0, u16* __restrict__ dst, int ldd, int drow0, float* lds, int tid) {
  float4 v[8];
#pragma unroll
  for (int p = 0; p < 8; ++p) {
    const int kr = p * 32 + (tid >> 3), c4 = tid & 7;
    const f32x4 t4 = __builtin_nontemporal_load((const f32x4*)(src + (size_t)(k0 + kr) * N + n0 + c4 * 4));
    v[p] = make_float4(t4[0], t4[1], t4[2], t4[3]);
  }
  __syncthreads();
#pragma unroll
  for (int p = 0; p < 8; ++p) {
    const int kr = p * 32 + (tid >> 3), c4 = tid & 7;
    float* d = lds + kr * 33 + c4 * 4;
    d[0] = v[p].x; d[1] = v[p].y; d[2] = v[p].z; d[3] = v[p].w;
  }
  __syncthreads();
  const int n = tid >> 3, kc = tid & 7;
  u16* o = dst + (size_t)(drow0 + n) * ldd + k0 + kc * 32;
#pragma unroll
  for (int q = 0; q < 4; ++q) {
    unsigned w[4];
#pragma unroll
    for (int j = 0; j < 4; ++j) w[j] = pack2(lds[(kc * 32 + q * 8 + 2 * j) * 33 + n], lds[(kc * 32 + q * 8 + 2 * j + 1) * 33 + n]);
    *(uint4*)(o + q * 8) = make_uint4(w[0], w[1], w[2], w[3]);
  }
}

DI void step_prep(const Ctx& c) {
  const int tid = otid(), lane = tid & 63, wid = tid >> 6;
  float* lf = (float*)c.lds;
  constexpr int N_MOD = 4 * 96, N_ROPE = 1, N_PAD = 4 * 6, TR_PER_LAYER = 868 + 192 + 128 + 512 + 512, N_TR = 4 * TR_PER_LAYER;
  constexpr int N_CC = 2 * 4 * 10 * 8;
  constexpr int TOTAL = N_MOD + N_ROPE + N_PAD + N_CC + N_TR;
  for (int it = blockIdx.x; it < TOTAL; it += gridDim.x) {
    if (it < N_MOD) {
      const int l = it / 96, ch = it % 96;
      __syncthreads();
      for (int e = tid; e < 3 * 1024; e += 256) {
        const int ci = e >> 10, k = e & 1023;
        const float x = (ci == 0) ? c.in[8][k] : c.in[7][(ci - 1) * 1024 + k];
        lf[e] = siluf(x);
      }
      __syncthreads();
      const float* w = c.in[9] + (size_t)l * 1024 * 6144 + ch * 64 + lane;
      float a0 = 0.f, a1 = 0.f, a2 = 0.f;
      const int kb = wid * 256;
#pragma unroll 16
      for (int k = 0; k < 256; ++k) {
        const float wv = __builtin_nontemporal_load(w + (size_t)(kb + k) * 6144);
        a0 += lf[kb + k] * wv; a1 += lf[1024 + kb + k] * wv; a2 += lf[2048 + kb + k] * wv;
      }
      __syncthreads();
      lf[3072 + (wid * 3 + 0) * 64 + lane] = a0; lf[3072 + (wid * 3 + 1) * 64 + lane] = a1; lf[3072 + (wid * 3 + 2) * 64 + lane] = a2;
      __syncthreads();
      if (tid < 192) {
        const int ci = tid >> 6;
        float s = c.in[10][l * 6144 + ch * 64 + lane];
#pragma unroll
        for (int w2 = 0; w2 < 4; ++w2) s += lf[3072 + (w2 * 3 + ci) * 64 + lane];
        ((float*)(c.ws + WS_MOD))[(l * 3 + ci) * 6144 + ch * 64 + lane] = s;
      }
    } else if (it < N_MOD + N_ROPE) {
      float2* rt = (float2*)(c.ws + WS_ROPE);
      for (int e = tid; e < 1024; e += 256) {
        const int pos = e >> 4, f = e & 15;
        const float inv = exp2f(-(float)f * (13.287712379549449f / 16.f));
        float ang = (float)pos * inv;
        const float k = rintf(ang * 0.15915494309189535f);
        ang = fmaf(-k, 6.2831854820251465f, ang);
        ang = fmaf(-k, -1.7484555e-7f, ang);
        rt[e] = make_float2(cosf(ang), sinf(ang));
      }
    } else if (it < N_MOD + N_ROPE + N_PAD) {
      const int j = it - N_MOD - N_ROPE, l = j / 6, part = j % 6;
      u16* d = (u16*)(c.ws + WS_WIN) + ((size_t)l * ZW + 1568 + part * 16) * 1024;
      for (int e = tid; e < 16 * 1024 / 8; e += 256) ((uint4*)d)[e] = make_uint4(0, 0, 0, 0);
    } else if (it < N_MOD + N_ROPE + N_PAD + N_CC) {
      const int j = it - N_MOD - N_ROPE - N_PAD, kg = j & 7, hs = (j >> 3) % 10, bl = j / 80;
      const bool na = hs >= 2; const int h = na ? hs - 2 : hs, H = na ? 8 : 2;
      const float* ksrc = c.in[na ? 5 : 3] + (size_t)bl * 512 * H * 64 + h * 64;
      const float* vsrc = c.in[na ? 6 : 4] + (size_t)bl * 512 * H * 64 + h * 64;
      u16* kd = (u16*)(c.ws + (na ? WS_KCN : WS_KCS)) + ((size_t)bl * H + h) * 512 * 64;
      u16* vd = (u16*)(c.ws + (na ? WS_VCN : WS_VCS)) + ((size_t)bl * H + h) * 64 * 512;
      for (int e = tid; e < 64 * 16; e += 256) {
        const int key = kg * 64 + (e >> 4), d4 = (e & 15) * 4;
        const float4 kv = *(const float4*)(ksrc + (size_t)key * H * 64 + d4);
        *(uint2*)(kd + key * 64 + d4) = make_uint2(pack2(kv.x, kv.y), pack2(kv.z, kv.w));
      }
      for (int e = tid; e < 64 * 16; e += 256) {
        const int key = kg * 64 + (e & 63), d4 = (e >> 6) * 4;
        const float4 vv = *(const float4*)(vsrc + (size_t)key * H * 64 + d4);
        vd[(d4 + 0) * 512 + key] = f2bf(vv.x); vd[(d4 + 1) * 512 + key] = f2bf(vv.y); vd[(d4 + 2) * 512 + key] = f2bf(vv.z); vd[(d4 + 3) * 512 + key] = f2bf(vv.w);
      }
    } else {
      const int j = it - N_MOD - N_ROPE - N_PAD - N_CC, l = j / TR_PER_LAYER;
      int r = j % TR_PER_LAYER;
      if (r < 868) {
        const int kt = r / 217, nt = r % 217, n0 = nt * 32;
        tr_tile(c.in[13] + (size_t)l * 1024 * 6944, 6944, kt * 256, n0, (u16*)(c.ws + WS_WIN) + (size_t)l * ZW * 1024, 1024, n0 < 1568 ? n0 : n0 + 96, lf, tid);
      } else if (r < 868 + 192) {
        r -= 868; const int s = r / 64, q = r % 64, kt = q / 32, nt = q % 32;
        tr_tile(c.in[25 + s] + (size_t)l * 512 * 1024, 1024, kt * 256, nt * 32, (u16*)(c.ws + WS_WP) + (size_t)(l * 3 + s) * 1024 * 512, 512, nt * 32, lf, tid);
      } else if (r < 868 + 192 + 128) {
        r -= 868 + 192; const int kt = r / 32, nt = r % 32;
        tr_tile(c.in[28] + (size_t)l * 1024 * 1024, 1024, kt * 256, nt * 32, (u16*)(c.ws + WS_WO) + (size_t)l * 1024 * 1024, 1024, nt * 32, lf, tid);
      } else if (r < 868 + 192 + 128 + 512) {
        r -= 868 + 192 + 128; const int kt = r / 128, nt = r % 128;
        tr_tile(c.in[29] + (size_t)l * 1024 * 4096, 4096, kt * 256, nt * 32, (u16*)(c.ws + WS_W1) + (size_t)l * 4096 * 1024, 1024, nt * 32, lf, tid);
      } else {
        r -= 868 + 192 + 128 + 512; const int kt = r / 32, nt = r % 32;
        tr_tile(c.in[30] + (size_t)l * 4096 * 1024, 1024, kt * 256, nt * 32, (u16*)(c.ws + WS_W2) + (size_t)l * 1024 * 4096, 4096, nt * 32, lf, tid);
      }
    }
  }
}

DI void step_norm(const Ctx& c, int layer, int which) {
  const int tid = otid(), lane = tid & 63, wid = tid >> 6;
  const float* nw = c.in[which ? 12 : 11] + layer * 1024;
  u16* hb = (u16*)(c.ws + WS_H);
  for (int t = blockIdx.x * 4 + wid; t < NTOK; t += gridDim.x * 4) {
    const float* x = (which == 0) ? xrow_src(c, layer, t) : (c.out + (size_t)t * DM);
    const float* mod = (const float*)(c.ws + WS_MOD) + (layer * 3 + cond_of(t)) * 6144 + (which ? 3072 : 0);
    float4 v[4]; float ss = 0.f;
#pragma unroll
    for (int i = 0; i < 4; ++i) { v[i] = *(const float4*)(x + (lane + 64 * i) * 4); ss += v[i].x * v[i].x + v[i].y * v[i].y + v[i].z * v[i].z + v[i].w * v[i].w; }
#pragma unroll
    for (int o = 32; o >= 1; o >>= 1) ss += __shfl_xor(ss, o);
    const float rstd = rsqrtf(ss * (1.f / 1024.f) + 1e-6f);
    float4 gq[4], shq[4], scq[4];
#pragma unroll
    for (int i = 0; i < 4; ++i) { const int k = (lane + 64 * i) * 4; gq[i] = *(const float4*)(nw + k); shq[i] = *(const float4*)(mod + k); scq[i] = *(const float4*)(mod + 1024 + k); }
#pragma unroll
    for (int i = 0; i < 4; ++i) {
      const int k = (lane + 64 * i) * 4;
      const float4 g = gq[i], sh = shq[i], sc = scq[i];
      const float y0 = v[i].x * rstd * g.x * (1.f + sc.x) + sh.x, y1 = v[i].y * rstd * g.y * (1.f + sc.y) + sh.y;
      const float y2 = v[i].z * rstd * g.z * (1.f + sc.z) + sh.z, y3 = v[i].w * rstd * g.w * (1.f + sc.w) + sh.w;
      *(uint2*)(hb + (size_t)t * 1024 + k) = make_uint2(pack2(y0, y1), pack2(y2, y3));
    }
  }
}

DI int swz(int row, int chunk) { return row * 64 + ((chunk ^ ((row >> 1) & 7)) << 3); }
typedef __attribute__((address_space(3))) unsigned lds_u32;
template <int MI>
DI void gemm_core(const u16* __restrict__ A, int lda, const u16* __restrict__ Bt, int ldb, int K, f32x4 (&acc)[4][4], u16* lds, int tid,
                  bool prestaged = false, const u16* __restrict__ An = nullptr, const u16* __restrict__ Btn = nullptr) {
  const int lane = tid & 63, wid = tid >> 6, wr = wid >> 1, wc = wid & 1;
  const int lrow = tid >> 3, lch = tid & 7;
  const int sch = (lch ^ ((lrow >> 1) & 7)) * 8;
  const u16* ap = A + (size_t)lrow * lda + sch;
  const u16* bp = Bt + (size_t)lrow * ldb + sch;
  const size_t sa32 = (size_t)32 * lda, sb32 = (size_t)32 * ldb;
  lds_u32* l3 = (lds_u32*)(lds) + tid * 4;
#define STAGE(bufw, ko) do { \
    __builtin_amdgcn_global_load_lds((const unsigned*)(ap + (ko)), l3 + (bufw), 16, 0, 0); \
    __builtin_amdgcn_global_load_lds((const unsigned*)(ap + sa32 + (ko)), l3 + (bufw) + 1024, 16, 0, 0); \
    __builtin_amdgcn_global_load_lds((const unsigned*)(ap + 2 * sa32 + (ko)), l3 + (bufw) + 2048, 16, 0, 0); \
    if (MI == 4) __builtin_amdgcn_global_load_lds((const unsigned*)(ap + 3 * sa32 + (ko)), l3 + (bufw) + 3072, 16, 0, 0); \
    __builtin_amdgcn_global_load_lds((const unsigned*)(bp + (ko)), l3 + (bufw) + 4096, 16, 0, 0); \
    __builtin_amdgcn_global_load_lds((const unsigned*)(bp + sb32 + (ko)), l3 + (bufw) + 5120, 16, 0, 0); \
    __builtin_amdgcn_global_load_lds((const unsigned*)(bp + 2 * sb32 + (ko)), l3 + (bufw) + 6144, 16, 0, 0); \
    __builtin_amdgcn_global_load_lds((const unsigned*)(bp + 3 * sb32 + (ko)), l3 + (bufw) + 7168, 16, 0, 0); } while (0)
  const int fr = lane & 15, fq = lane >> 4;
  const int nkt = K >> 6;
  if (!prestaged) {
    __syncthreads();
    STAGE(0, 0);
  }
  for (int kt = 0; kt < nkt; ++kt) {
    asm volatile("s_waitcnt vmcnt(0)" ::: "memory");
    __builtin_amdgcn_s_barrier();
    if (kt + 1 < nkt) STAGE(((kt + 1) & 1) * 8192, (kt + 1) * 64);
    else if (An) {
      ap = An + (size_t)lrow * lda + sch; bp = Btn + (size_t)lrow * ldb + sch;
      STAGE(0, 0);
    }
    const u16* sa = lds + (kt & 1) * 16384;
    const u16* sb = sa + 8192;
#pragma unroll
    for (int ks = 0; ks < 2; ++ks) {
      bf16x8 af[4], bfr[4];
#pragma unroll
      for (int i = 0; i < MI; ++i) af[i] = *(const bf16x8*)(sa + swz(wr * (16 * MI) + i * 16 + fr, ks * 4 + fq));
#pragma unroll
      for (int j = 0; j < 4; ++j) bfr[j] = *(const bf16x8*)(sb + swz(wc * 64 + j * 16 + fr, ks * 4 + fq));
#pragma unroll
      for (int i = 0; i < MI; ++i)
#pragma unroll
        for (int j = 0; j < 4; ++j) acc[i][j] = __builtin_amdgcn_mfma_f32_16x16x32_bf16(bfr[j], af[i], acc[i][j], 0, 0, 0);
    }
  }
#undef STAGE
}
DI int swz32(int row, int chunk) { return row * 32 + ((chunk ^ ((0 - (row >> 2)) & 3)) << 3); }
template <int MI>
DI void gemm_core32(const u16* __restrict__ A, int lda, const u16* __restrict__ Bt, int ldb, int K, f32x4 (&acc)[MI][4], u16* lds, int tid,
                    bool prestaged, const u16* __restrict__ An, const u16* __restrict__ Btn, int& base) {
  constexpr int ABYTES = 32 * MI * 64, SLOT_U32 = (ABYTES + 8192) / 4, SLOT_U16 = (ABYTES + 8192) / 2, P = MI / 2 + 2;
  const int lane = tid & 63, wid = tid >> 6, wr = wid >> 1, wc = wid & 1;
  const int lrow = tid >> 2, lch = tid & 3;
  const int sch = (lch ^ ((0 - (lrow >> 2)) & 3)) * 8;
  const u16* ap = A + (size_t)lrow * lda + sch;
  const u16* bp = Bt + (size_t)lrow * ldb + sch;
  const size_t sa64 = (size_t)64 * lda, sb64 = (size_t)64 * ldb;
  lds_u32* l3 = (lds_u32*)(lds) + tid * 4;
#define STAGE32(slot, pa, pb, ko) do { lds_u32* _l = l3 + (slot) * SLOT_U32; \
    _Pragma("unroll") for (int _i = 0; _i < MI / 2; ++_i) __builtin_amdgcn_global_load_lds((const unsigned*)((pa) + _i * sa64 + (ko)), _l + _i * 1024, 16, 0, 0); \
    __builtin_amdgcn_global_load_lds((const unsigned*)((pb) + (ko)), _l + ABYTES / 4, 16, 0, 0); \
    __builtin_amdgcn_global_load_lds((const unsigned*)((pb) + sb64 + (ko)), _l + ABYTES / 4 + 1024, 16, 0, 0); } while (0)
  const int fr = lane & 15, fq = lane >> 4;
  const int nkt = K >> 5;
  const int aoff = swz32(wr * (16 * MI) + fr, fq), boff = ABYTES / 2 + swz32(wc * 64 + fr, fq);
  if (!prestaged) {
    base = 0;
    __syncthreads();
    STAGE32(0, ap, bp, 0);
    STAGE32(1, ap, bp, 32);
  }
  int slot = base;
  for (int kt = 0; kt < nkt; ++kt) {
    if (kt > 0 && (kt + 1 < nkt || An)) asm volatile("s_waitcnt vmcnt(%0)" :: "n"(P) : "memory");
    else asm volatile("s_waitcnt vmcnt(0)" ::: "memory");
    __builtin_amdgcn_s_barrier();
    const int s2 = (slot == 0) ? 2 : slot - 1;
    if (kt + 2 < nkt) STAGE32(s2, ap, bp, (kt + 2) * 32);
    else if (An) { const u16* apn = An + (size_t)lrow * lda + sch; const u16* bpn = Btn + (size_t)lrow * ldb + sch; STAGE32(s2, apn, bpn, (kt + 2 - nkt) * 32); }
    const u16* sa = lds + slot * SLOT_U16;
    bf16x8 af[MI], bfr[4];
#pragma unroll
    for (int i = 0; i < MI; ++i) af[i] = *(const bf16x8*)(sa + aoff + i * 16 * 32);
#pragma unroll
    for (int j = 0; j < 4; ++j) bfr[j] = *(const bf16x8*)(sa + boff + j * 16 * 32);
#pragma unroll
    for (int i = 0; i < MI; ++i)
#pragma unroll
      for (int j = 0; j < 4; ++j) acc[i][j] = __builtin_amdgcn_mfma_f32_16x16x32_bf16(bfr[j], af[i], acc[i][j], 0, 0, 0);
    slot = (slot == 2) ? 0 : slot + 1;
  }
  base = slot;
#undef STAGE32
}
template <int MI>
DI void zero_acc_n(f32x4 (&acc)[MI][4]) {
#pragma unroll
  for (int i = 0; i < MI; ++i)
#pragma unroll
    for (int j = 0; j < 4; ++j) acc[i][j] = f32x4{0.f, 0.f, 0.f, 0.f};
}
DI void zero_acc(f32x4 (&acc)[4][4]) {
#pragma unroll
  for (int i = 0; i < 4; ++i)
#pragma unroll
    for (int j = 0; j < 4; ++j) acc[i][j] = f32x4{0.f, 0.f, 0.f, 0.f};
}

DI bool sq_tile(int k, int nmt, int nnt, int& mt, int& nt) {
  if (gridDim.x != 512) { const int t = blockIdx.x + k * gridDim.x; mt = t % nmt; nt = t / nmt; return t < nmt * nnt; }
  const int x = blockIdx.x & 7, s = blockIdx.x >> 3, nmg = nmt >> 3;
  const int nst = nmg * ((nnt + 7) >> 3), last = ((nst + 7) >> 3) - 1;
  if (k == last && nst - 8 * last == 4) {
    const int st = k * 8 + (x & 3);
    if (s >= 32) return false;
    mt = (st % nmg) * 8 + (s & 7); nt = (st / nmg) * 8 + (x >> 2) * 4 + (s >> 3);
    return nt < nnt;
  }
  const int st = k * 8 + x;
  mt = (st % nmg) * 8 + (s & 7); nt = (st / nmg) * 8 + (s >> 3);
  return st < nst && nt < nnt;
}
DI int sq_rounds(int nmt, int nnt) { return (gridDim.x != 512) ? (nmt * nnt + gridDim.x - 1) / gridDim.x : ((nmt >> 3) * ((nnt + 7) >> 3) + 7) >> 3; }
DI void epi_put(u16* wl, int row, int j, int fq, unsigned lo, unsigned hi) {
  *(uint2*)(wl + row * 64 + (((j * 2 + (fq >> 1)) ^ (row & 7)) << 3) + (fq & 1) * 4) = make_uint2(lo, hi);
}
template <int MI>
DI void epi_flush(const u16* wl, u16* gbase, size_t ld, int lane) {
#pragma unroll
  for (int p = 0; p < MI * 2; ++p) {
    const int row = p * 8 + (lane >> 3), ch = lane & 7;
    const u32x4 v = *(const u32x4*)(wl + row * 64 + (ch << 3));
    __builtin_nontemporal_store(v, (u32x4*)(gbase + (size_t)row * ld + ((ch ^ (row & 7)) << 3)));
  }
}
DI void step_gemm_in(const Ctx& c, int layer) {
  const int tid = otid(), lane = tid & 63, wid = tid >> 6, wr = wid >> 1, wc = wid & 1, fr = lane & 15, fq = lane >> 4;
  const u16* hb = (const u16*)(c.ws + WS_H);
  const u16* wt = (const u16*)(c.ws + WS_WIN) + (size_t)layer * ZW * 1024;
  u16* zb = (u16*)(c.ws + WS_ZB);
  const float2* rope = (const float2*)(c.ws + WS_ROPE);
  constexpr int MI = 6, CH = 2, BM = 32 * MI, NMT = NTOK / BM, SLOT_U16 = (32 * MI * 64 + 8192) / 2;
  int rbase = 0;
  bool pre = false;
  for (int k = 0, nk = sq_rounds(NMT, 55); k < nk; ++k) {
    int mt, nt; if (!sq_tile(k, NMT, 55, mt, nt)) continue;
    const int m0 = mt * BM, n0 = nt * 128;
    int mtn = 0, ntn2 = 0; const bool hn = (k + 1 < nk) && sq_tile(k + 1, NMT, 55, mtn, ntn2);
    f32x4 acc[MI][4]; zero_acc_n<MI>(acc);
    gemm_core32<MI>(hb + (size_t)m0 * 1024, 1024, wt + (size_t)n0 * 1024, 1024, 1024, acc, (u16*)c.lds, tid, pre,
                    hn ? hb + (size_t)(mtn * BM) * 1024 : nullptr, hn ? wt + (size_t)(ntn2 * 128) * 1024 : nullptr, rbase);
    pre = hn;
    const int nb = n0 + wc * 64, jb = nb >> 6;
    __syncthreads();
    u16* wl = (u16*)c.lds + ((rbase == 0) ? 2 : rbase - 1) * SLOT_U16 + wid * 2048;
    int kind = 0;
    if (jb < 4) kind = 7; else if (jb < 26) kind = 0; else if (jb < 34) kind = 1; else if (jb < 36) kind = 2; else if (jb < 38) kind = 3;
    else if (jb < 46) kind = 4; else if (jb < 54) kind = 5; else if (jb < 62) kind = 6;
    const bool isnorm = (kind == 1 || kind == 2 || kind == 4 || kind == 5);
    const float* gwp = c.in[kind == 1 ? 19 : kind == 2 ? 20 : kind == 4 ? 22 : 23] + layer * 64;
    float4 gwv[4];
    if (isnorm) {
#pragma unroll
      for (int j = 0; j < 4; ++j) gwv[j] = *(const float4*)(gwp + j * 16 + fq * 4);
    }
#pragma unroll
    for (int ps = 0; ps < MI / CH; ++ps) {
#pragma unroll
    for (int ii = 0; ii < CH; ++ii) {
      const int i = ps * CH + ii;
      const int m = m0 + wr * (16 * MI) + i * 16 + fr;
      const bool lat = m >= NCTX;
      float v[4][4];
#pragma unroll
      for (int j = 0; j < 4; ++j)
#pragma unroll
        for (int r = 0; r < 4; ++r) v[j][r] = acc[i][j][r];
      if (isnorm) {
        float ss = 0.f;
#pragma unroll
        for (int j = 0; j < 4; ++j)
#pragma unroll
          for (int r = 0; r < 4; ++r) ss += v[j][r] * v[j][r];
        ss += __shfl_xor(ss, 16); ss += __shfl_xor(ss, 32);
        const float rstd = rsqrtf(ss * (1.f / 64.f) + 1e-6f);
#pragma unroll
        for (int j = 0; j < 4; ++j) {
          const float4 g = gwv[j];
          v[j][0] *= rstd * g.x; v[j][1] *= rstd * g.y; v[j][2] *= rstd * g.z; v[j][3] *= rstd * g.w;
        }
      }
      if (!lat && (kind == 2 || kind == 3 || kind == 5 || kind == 6)) {
        const int b = m >> 8, s = m & 255;
        float* o;
        if (kind == 2) o = c.out + O_SWK + ((size_t)((b * 4 + layer) * 256 + s)) * 128 + (jb - 34) * 64;
        else if (kind == 3) o = c.out + O_SWV + ((size_t)((b * 4 + layer) * 256 + s)) * 128 + (jb - 36) * 64;
        else if (kind == 5) o = c.out + O_NAK + ((size_t)((b * 4 + layer) * 256 + s)) * 512 + (jb - 46) * 64;
        else o = c.out + O_NAV + ((size_t)((b * 4 + layer) * 256 + s)) * 512 + (jb - 54) * 64;
#pragma unroll
        for (int j = 0; j < 4; ++j) *(float4*)(o + j * 16 + fq * 4) = make_float4(v[j][0], v[j][1], v[j][2], v[j][3]);
      }
      if (lat && (kind == 1 || kind == 2)) {
        const int nidx = (m - NCTX) & 1023, prow = nidx >> 6, pcol = nidx & 63;
#pragma unroll
        for (int r = 0; r < 4; ++r) {
          const float2 a = rope[prow * 16 + fq * 4 + r], b2 = rope[pcol * 16 + fq * 4 + r];
          const float x1 = v[0][r], x2 = v[1][r], y1 = v[2][r], y2 = v[3][r];
          v[0][r] = x1 * a.x - x2 * a.y; v[1][r] = x1 * a.y + x2 * a.x;
          v[2][r] = y1 * b2.x - y2 * b2.y; v[3][r] = y1 * b2.y + y2 * b2.x;
        }
      }
      if (kind == 3 || kind == 6) {
        u16* vt = (u16*)(c.ws + (kind == 3 ? WS_VTS : WS_VTN)) + (size_t)((kind == 3 ? jb - 36 : jb - 54) * 64) * NTOK + m;
#pragma unroll
        for (int j = 0; j < 4; ++j)
#pragma unroll
          for (int r = 0; r < 4; ++r) vt[(size_t)(j * 16 + fq * 4 + r) * NTOK] = f2bf(v[j][r]);
      }
      const float sc = (kind == 1 || kind == 4 || kind == 7) ? 0.125f : 1.f;
#pragma unroll
      for (int j = 0; j < 4; ++j) epi_put(wl, ii * 16 + fr, j, fq, pack2(v[j][0] * sc, v[j][1] * sc), pack2(v[j][2] * sc, v[j][3] * sc));
    }
    epi_flush<CH>(wl, zb + (size_t)(m0 + wr * (16 * MI) + ps * CH * 16) * ZW + nb, ZW, lane);
    }
  }
}

DI void step_gemm_merge(const Ctx& c, int layer) {
  const int tid = otid(), lane = tid & 63, wid = tid >> 6, wr = wid >> 1, wc = wid & 1, fr = lane & 15, fq = lane >> 4;
  const u16* att = (const u16*)(c.ws + WS_ATT);
  const u16* zb = (const u16*)(c.ws + WS_ZB);
  u16* mg = (u16*)(c.ws + WS_MRG);
  constexpr int MI = 3, BM = 32 * MI, NMT = NTOK / BM, NT = NMT * 8;
  bool pre = false;
  for (int k = 0, nk = sq_rounds(NMT, 8); k < nk; ++k) {
    int mt, nt; if (!sq_tile(k, NMT, 8, mt, nt)) continue;
    const int m0 = mt * BM, n0 = nt * 128;
    int mtn = 0, ntn2 = 0; const bool hn = (k + 1 < nk) && sq_tile(k + 1, NMT, 8, mtn, ntn2);
    f32x4 acc[4][4]; zero_acc(acc);
#pragma unroll 1
    for (int s = 0; s < 3; ++s) {
      const u16* wp = (const u16*)(c.ws + WS_WP);
      const bool hs = (s < 2) || hn;
      const u16* an = (s < 2) ? att + (size_t)m0 * ATTW + (s + 1) * 512 : att + (size_t)(mtn * BM) * ATTW;
      const u16* bn = (s < 2) ? wp + ((size_t)(layer * 3 + s + 1) * 1024 + n0) * 512 : wp + ((size_t)(layer * 3) * 1024 + ntn2 * 128) * 512;
      uint2 gq[MI][4], gnq[MI][4];
#pragma unroll
      for (int i = 0; i < MI; ++i) {
        const int m = m0 + wr * (16 * MI) + i * 16 + fr;
#pragma unroll
        for (int j = 0; j < 4; ++j) {
          const int n = n0 + wc * 64 + j * 16 + fq * 4;
          gq[i][j] = *(const uint2*)(zb + (size_t)m * ZW + C_GA + s * 1024 + n);
          gnq[i][j] = *(const uint2*)(zb + (size_t)m * ZW + C_GA + (s < 2 ? s + 1 : s) * 1024 + n);
        }
      }
      gemm_core<MI>(att + (size_t)m0 * ATTW + s * 512, ATTW, wp + ((size_t)(layer * 3 + s) * 1024 + n0) * 512, 512, 512, acc, (u16*)c.lds, tid, pre, hs ? an : nullptr, hs ? bn : nullptr);
      pre = hs;
#pragma unroll
      for (int i = 0; i < MI; ++i) {
#pragma unroll
        for (int j = 0; j < 4; ++j) {
          const uint2 g = gq[i][j];
          float f0 = fmaxf(sigmoidf(bflo(g.x)), 1e-6f), f1 = fmaxf(sigmoidf(bfhi(g.x)), 1e-6f), f2 = fmaxf(sigmoidf(bflo(g.y)), 1e-6f), f3 = fmaxf(sigmoidf(bfhi(g.y)), 1e-6f);
          if (s < 2) {
            const uint2 gn = gnq[i][j];
            f0 /= fmaxf(sigmoidf(bflo(gn.x)), 1e-6f); f1 /= fmaxf(sigmoidf(bfhi(gn.x)), 1e-6f); f2 /= fmaxf(sigmoidf(bflo(gn.y)), 1e-6f); f3 /= fmaxf(sigmoidf(bfhi(gn.y)), 1e-6f);
          }
          acc[i][j][0] *= f0; acc[i][j][1] *= f1; acc[i][j][2] *= f2; acc[i][j][3] *= f3;
        }
      }
    }
#pragma unroll
    for (int i = 0; i < MI; ++i) {
      const int m = m0 + wr * (16 * MI) + i * 16 + fr;
#pragma unroll
      for (int j = 0; j < 4; ++j) {
        const int n = n0 + wc * 64 + j * 16 + fq * 4;
        *(uint2*)(mg + (size_t)m * 1024 + n) = make_uint2(pack2(acc[i][j][0], acc[i][j][1]), pack2(acc[i][j][2], acc[i][j][3]));
      }
    }
  }
}

template <int MODE>
DI void step_gemm_std(const Ctx& c, int layer) {
  const int tid = otid(), lane = tid & 63, wid = tid >> 6, wr = wid >> 1, wc = wid & 1, fr = lane & 15, fq = lane >> 4;
  const u16* A = (const u16*)(c.ws + (MODE == 0 ? WS_MRG : MODE == 1 ? WS_H : WS_U));
  const int lda = (MODE == 2) ? HID : 1024, K = lda;
  const u16* Bt = (const u16*)(c.ws + (MODE == 0 ? WS_WO : MODE == 1 ? WS_W1 : WS_W2)) + (size_t)layer * 1024 * 4096 / (MODE == 0 ? 4 : 1);
  constexpr int ntn = (MODE == 1) ? 32 : 8;
  constexpr int MI = (MODE == 1) ? 6 : 3, CH = 2, BM = 32 * MI, NMT = NTOK / BM, SLOT_U16 = (32 * MI * 64 + 8192) / 2;
  int rbase = 0;
  bool pre = false;
  for (int k = 0, nk = sq_rounds(NMT, ntn); k < nk; ++k) {
    int mt, nt; if (!sq_tile(k, NMT, ntn, mt, nt)) continue;
    const int m0 = mt * BM, n0 = nt * 128;
    int mtn = 0, ntn2 = 0; const bool hn = (k + 1 < nk) && sq_tile(k + 1, NMT, ntn, mtn, ntn2);
    f32x4 acc[MI][4]; zero_acc_n<MI>(acc);
    if (MODE == 1) gemm_core32<MI>(A + (size_t)m0 * lda, lda, Bt + (size_t)n0 * K, K, K, acc, (u16*)c.lds, tid, pre,
                                   hn ? A + (size_t)(mtn * BM) * lda : nullptr, hn ? Bt + (size_t)(ntn2 * 128) * K : nullptr, rbase);
    else gemm_core<3>(A + (size_t)m0 * lda, lda, Bt + (size_t)n0 * K, K, K, (f32x4 (&)[4][4])acc, (u16*)c.lds, tid, pre,
                      hn ? A + (size_t)(mtn * BM) * lda : nullptr, hn ? Bt + (size_t)(ntn2 * 128) * K : nullptr);
    pre = hn;
    u16* wl = (MODE == 1) ? (u16*)c.lds + ((rbase == 0) ? 2 : rbase - 1) * SLOT_U16 + wid * 2048 : (u16*)c.lds + 16384 + wid * 4096;
    if (MODE == 1) __syncthreads();
#pragma unroll
    for (int i = 0; i < MI; ++i) {
      const int m = m0 + wr * (16 * MI) + i * 16 + fr;
      const float* gate = (const float*)(c.ws + WS_MOD) + (layer * 3 + cond_of(m)) * 6144 + (MODE == 0 ? 2048 : 5120);
#pragma unroll
      for (int j = 0; j < 4; ++j) {
        const int n = n0 + wc * 64 + j * 16 + fq * 4;
        if (MODE == 1) {
          float r0 = fmaxf(acc[i][j][0], 0.f), r1 = fmaxf(acc[i][j][1], 0.f), r2 = fmaxf(acc[i][j][2], 0.f), r3 = fmaxf(acc[i][j][3], 0.f);
          epi_put(wl, (i % CH) * 16 + fr, j, fq, pack2(r0 * r0, r1 * r1), pack2(r2 * r2, r3 * r3));
        } else {
          const float* xs = (MODE == 0) ? xrow_src(c, layer, m) : (c.out + (size_t)m * DM);
          const float4 xv = *(const float4*)(xs + n), g = *(const float4*)(gate + n);
          const f32x4 yv = {xv.x + g.x * acc[i][j][0], xv.y + g.y * acc[i][j][1], xv.z + g.z * acc[i][j][2], xv.w + g.w * acc[i][j][3]};
          __builtin_nontemporal_store(yv, (f32x4*)(c.out + (size_t)m * DM + n));
        }
      }
      if (MODE == 1 && (i % CH) == CH - 1) epi_flush<CH>(wl, (u16*)(c.ws + WS_U) + (size_t)(m0 + wr * (16 * MI) + (i / CH) * CH * 16) * HID + n0 + wc * 64, HID, lane);
    }
  }
}

DI int crow(int reg, int h) { return (reg & 3) + 8 * (reg >> 2) + 4 * h; }
DI void attn_item(const Ctx& c, int layer, int kind, int b, int hq, int qb) {
  const int tid = otid(), lane = tid & 63, wid = tid >> 6, ql = lane & 31, hh = lane >> 5;
  u16* Ks = (u16*)c.lds;
  u16* Vt = Ks + 4096;
  float* rpb = (float*)(c.lds + 8192 + 9216);
  const u16* zb = (const u16*)(c.ws + WS_ZB);
  u16* att = (u16*)(c.ws + WS_ATT);
  const bool isB = (kind == 0 || kind == 2);
  const int qcol = isB ? C_BQ + hq * 64 : C_CQ + hq * 64;
  const int kcol = isB ? C_BK + (hq >> 2) * 64 : C_CK + hq * 64;
  const int vcol = isB ? C_BV + (hq >> 2) * 64 : C_CV + hq * 64;
  const int outcol = isB ? 512 + hq * 64 : 1024 + hq * 64;
  int qtok0, ntiles, zrow0 = 0, tlo = 0, rs0 = 0;
  const u16 *kc = nullptr, *vc = nullptr;
  const int hk = isB ? (hq >> 2) : hq;
  const u16* vtl = (const u16*)(c.ws + (isB ? WS_VTS : WS_VTN)) + (size_t)(hk * 64) * NTOK;
  if (kind < 2) { qtok0 = b * 256 + qb * 128; ntiles = 4; zrow0 = b * 256; }
  else if (kind == 2) {
    qtok0 = NCTX + b * 1024 + qb * 128;
    tlo = (qb == 0) ? 2 : 0; const int thi = (qb == 7) ? 4 : 6; ntiles = 8 + thi - tlo;
    zrow0 = NCTX + b * 1024 + (qb - 1) * 128 + tlo * 64;
    kc = (const u16*)(c.ws + WS_KCS) + ((size_t)(b * 4 + layer) * 2 + hk) * 512 * 64; vc = (const u16*)(c.ws + WS_VCS) + ((size_t)(b * 4 + layer) * 2 + hk) * 64 * 512;
  } else {
    qtok0 = NCTX + b * 1024 + qb * 128;
    rs0 = min(max(2 * qb - 4, 0), 8); const int rs1 = min(max(2 * qb - 3, 0), 8); ntiles = 8 + rs1 + 8 - rs0;
    zrow0 = NCTX + b * 1024 + rs0 * 64;
    kc = (const u16*)(c.ws + WS_KCN) + ((size_t)(b * 4 + layer) * 8 + hk) * 512 * 64; vc = (const u16*)(c.ws + WS_VCN) + ((size_t)(b * 4 + layer) * 8 + hk) * 64 * 512;
  }
  const int ncache = (kind >= 2) ? 8 : 0;
  bf16x8 qf[4];
  {
    const u16* qp = zb + (size_t)(qtok0 + wid * 32 + ql) * ZW + qcol + hh * 8;
#pragma unroll
    for (int ks = 0; ks < 4; ++ks) qf[ks] = *(const bf16x8*)(qp + ks * 16);
  }
  __syncthreads();
  if (kind == 3) { for (int e = tid; e < 465; e += 256) rpb[e] = c.in[24][(size_t)(layer * 8 + hq) * 465 + e]; }
  float m_run, l_run;
  if (isB) { m_run = c.in[21][layer * 8 + hq]; l_run = (hh == 0) ? 1.f : 0.f; } else { m_run = -1e30f; l_run = 0.f; }
  f32x16 o0, o1;
#pragma unroll
  for (int r = 0; r < 16; ++r) { o0[r] = 0.f; o1[r] = 0.f; }
  const int qpos = qb * 128 + wid * 32 + ql;
  const int qr = 2 * qb + (wid >> 1), qc = (wid & 1) * 32 + ql;
  const int wrs = min(max(qr - 4, 0), 8), ccs = min(max(qc - 8, 0), 48);

  uint4 rk0, rk1, rv0, rv1;
  const int srow = tid >> 3, sc8 = tid & 7;
  auto prefetch = [&](int t) {
    const u16 *kp, *vp; size_t kst, vst;
    if (t < ncache) { kp = kc + (size_t)t * 64 * 64; kst = 64; vp = vc + t * 64; vst = 512; }
    else { const int row0 = zrow0 + (t - ncache) * 64; kp = zb + (size_t)row0 * ZW + kcol; kst = ZW; vp = vtl + row0; vst = NTOK; }
    rk0 = *(const uint4*)(kp + (size_t)srow * kst + sc8 * 8); rk1 = *(const uint4*)(kp + (size_t)(srow + 32) * kst + sc8 * 8);
    rv0 = *(const uint4*)(vp + (size_t)srow * vst + sc8 * 8); rv1 = *(const uint4*)(vp + (size_t)(srow + 32) * vst + sc8 * 8);
  };
  auto stash = [&](int) {
    *(uint4*)(Ks + swz(srow, sc8)) = rk0; *(uint4*)(Ks + swz(srow + 32, sc8)) = rk1;
    *(uint4*)(Vt + srow * 72 + sc8 * 8) = rv0; *(uint4*)(Vt + (srow + 32) * 72 + sc8 * 8) = rv1;
  };

  prefetch(0);
  for (int t = 0; t < ntiles; ++t) {
    __syncthreads();
    stash(t);
    __syncthreads();
    if (t + 1 < ntiles) prefetch(t + 1);
    bool skip = false;
    int kp0 = 0, kr = 0;
    const bool local = (t >= ncache) && kind >= 2;
    if (local && kind == 2) {
      kp0 = (qb - 1) * 128 + (tlo + t - ncache) * 64;
      const int qlo = qb * 128 + wid * 32;
      skip = (kp0 + 63 < qlo - 128) || (kp0 > qlo + 31 + 128);
    } else if (local && kind == 3) {
      kr = rs0 + (t - ncache);
      skip = (kr < wrs) || (kr >= wrs + 8);
    }
    if (!skip) {
      f32x16 s0, s1;
#pragma unroll
      for (int r = 0; r < 16; ++r) { s0[r] = 0.f; s1[r] = 0.f; }
#pragma unroll
      for (int ks = 0; ks < 4; ++ks) {
        const bf16x8 k0 = *(const bf16x8*)(Ks + swz(ql, ks * 2 + hh));
        const bf16x8 k1 = *(const bf16x8*)(Ks + swz(32 + ql, ks * 2 + hh));
        s0 = __builtin_amdgcn_mfma_f32_32x32x16_bf16(k0, qf[ks], s0, 0, 0, 0);
        s1 = __builtin_amdgcn_mfma_f32_32x32x16_bf16(k1, qf[ks], s1, 0, 0, 0);
      }
      if (local && kind == 2) {
#pragma unroll
        for (int r = 0; r < 16; ++r) {
          const int d0 = kp0 + crow(r, hh) - qpos, d1 = d0 + 32;
          if (d0 < -128 || d0 > 128) s0[r] = -1e30f;
          if (d1 < -128 || d1 > 128) s1[r] = -1e30f;
        }
      } else if (local && kind == 3) {
        const float* rp = rpb + (kr - qr + 7) * 31 + 15 - qc;
#pragma unroll
        for (int r = 0; r < 16; ++r) {
          const int k0c = crow(r, hh), k1c = k0c + 32;
          s0[r] = (k0c >= ccs && k0c < ccs + 16) ? s0[r] + rp[k0c] : -1e30f;
          s1[r] = (k1c >= ccs && k1c < ccs + 16) ? s1[r] + rp[k1c] : -1e30f;
        }
      }
      float mx = s0[0];
#pragma unroll
      for (int r = 1; r < 16; ++r) mx = fmaxf(mx, s0[r]);
#pragma unroll
      for (int r = 0; r < 16; ++r) mx = fmaxf(mx, s1[r]);
      mx = fmaxf(mx, __shfl_xor(mx, 32));
      const float m_new = fmaxf(m_run, mx);
      const float alpha = __expf(m_run - m_new);
      m_run = m_new;
      float rs = 0.f;
#pragma unroll
      for (int r = 0; r < 16; ++r) { s0[r] = __expf(s0[r] - m_new); s1[r] = __expf(s1[r] - m_new); rs += s0[r] + s1[r]; }
      l_run = l_run * alpha + rs;
#pragma unroll
      for (int r = 0; r < 16; ++r) { o0[r] *= alpha; o1[r] *= alpha; }
#pragma unroll
      for (int kt = 0; kt < 2; ++kt) {
#pragma unroll
        for (int s = 0; s < 2; ++s) {
          u32x4 pw;
          if (kt == 0) { pw[0] = pack2(s0[8 * s + 0], s0[8 * s + 1]); pw[1] = pack2(s0[8 * s + 2], s0[8 * s + 3]); pw[2] = pack2(s0[8 * s + 4], s0[8 * s + 5]); pw[3] = pack2(s0[8 * s + 6], s0[8 * s + 7]); }
          else { pw[0] = pack2(s1[8 * s + 0], s1[8 * s + 1]); pw[1] = pack2(s1[8 * s + 2], s1[8 * s + 3]); pw[2] = pack2(s1[8 * s + 4], s1[8 * s + 5]); pw[3] = pack2(s1[8 * s + 6], s1[8 * s + 7]); }
          const bf16x8 pf = __builtin_bit_cast(bf16x8, pw);
          const int ko = kt * 32 + 16 * s + 4 * hh;
          {
            const u32x2 lo = *(const u32x2*)(Vt + ql * 72 + ko), hi = *(const u32x2*)(Vt + ql * 72 + ko + 8);
            u32x4 vw; vw[0] = lo[0]; vw[1] = lo[1]; vw[2] = hi[0]; vw[3] = hi[1];
            o0 = __builtin_amdgcn_mfma_f32_32x32x16_bf16(__builtin_bit_cast(bf16x8, vw), pf, o0, 0, 0, 0);
          }
          {
            const u32x2 lo = *(const u32x2*)(Vt + (32 + ql) * 72 + ko), hi = *(const u32x2*)(Vt + (32 + ql) * 72 + ko + 8);
            u32x4 vw; vw[0] = lo[0]; vw[1] = lo[1]; vw[2] = hi[0]; vw[3] = hi[1];
            o1 = __builtin_amdgcn_mfma_f32_32x32x16_bf16(__builtin_bit_cast(bf16x8, vw), pf, o1, 0, 0, 0);
          }
        }
      }
    }
  }
  const float lt = l_run + __shfl_xor(l_run, 32);
  const float inv = 1.f / lt;
  u16* op = att + (size_t)(qtok0 + wid * 32 + ql) * ATTW + outcol + 4 * hh;
#pragma unroll
  for (int g = 0; g < 4; ++g) {
    *(uint2*)(op + 8 * g) = make_uint2(pack2(o0[4 * g] * inv, o0[4 * g + 1] * inv), pack2(o0[4 * g + 2] * inv, o0[4 * g + 3] * inv));
    *(uint2*)(op + 32 + 8 * g) = make_uint2(pack2(o1[4 * g] * inv, o1[4 * g + 1] * inv), pack2(o1[4 * g + 2] * inv, o1[4 * g + 3] * inv));
  }
}

DI void gla_g1_item(const Ctx& c, int layer, int cu, int h, int dir) {
  const int tid = otid(), lane = tid & 63, wid = tid >> 6, ql = lane & 31, hh = lane >> 5;
  u16* Qs = (u16*)c.lds;
  u16* KPs = Qs + 2048;
  u16* KPT = KPs + 2048;
  u16* VT = KPT + 64 * 40;
  float* al = (float*)(VT + 128 * 40);
  float* tot = al + 512;
  const u16* zb = (const u16*)(c.ws + WS_ZB);
  const int tok0 = cu * 32, idx = (cu * 4 + h) * 2 + dir;
  const int d = lane, part = wid;
  __syncthreads();
  if (tid < 128) {
    const int i = tid >> 2, c4 = tid & 3, tok = tok0 + (dir ? 31 - i : i);
    const uint2 av = *(const uint2*)(zb + (size_t)tok * ZW + C_ALF + dir * 16 + c4 * 4);
    *(float4*)(al + i * 16 + c4 * 4) = make_float4(bflo(av.x), bfhi(av.x), bflo(av.y), bfhi(av.y));
  }
  float qv[8], kv[8];
#pragma unroll
  for (int ii = 0; ii < 8; ++ii) {
    const int i = part * 8 + ii, tok = tok0 + (dir ? 31 - i : i);
    qv[ii] = bf2f(zb[(size_t)tok * ZW + C_AQ + h * 64 + d]);
    kv[ii] = bf2f(zb[(size_t)tok * ZW + C_AK + h * 64 + d]);
  }
  uint4 vr0, vr1;
  {
    const int q0 = tid, q1 = tid + 256;
    const int i0 = q0 >> 4, i1 = q1 >> 4;
    vr0 = *(const uint4*)(zb + (size_t)(tok0 + (dir ? 31 - i0 : i0)) * ZW + C_AV + h * 128 + (q0 & 15) * 8);
    vr1 = *(const uint4*)(zb + (size_t)(tok0 + (dir ? 31 - i1 : i1)) * ZW + C_AV + h * 128 + (q1 & 15) * 8);
  }
  float w2[16];
  {
    const float* wp = c.in[dir ? 16 : 14] + (size_t)layer * 16 * 256 + h * 64 + d;
#pragma unroll
    for (int r = 0; r < 16; ++r) w2[r] = wp[r * 256];
  }
  const float b2 = c.in[dir ? 17 : 15][layer * 256 + h * 64 + d];
  __syncthreads();
  float cl[8];
  {
    float run = 0.f;
#pragma unroll
    for (int ii = 0; ii < 8; ++ii) {
      const int i = part * 8 + ii;
      float x = b2;
#pragma unroll
      for (int r4 = 0; r4 < 4; ++r4) {
        const float4 a4 = *(const float4*)(al + i * 16 + r4 * 4);
        x += a4.x * w2[r4 * 4] + a4.y * w2[r4 * 4 + 1] + a4.z * w2[r4 * 4 + 2] + a4.w * w2[r4 * 4 + 3];
      }
      const float ls = fminf(x, 0.f) - __logf(1.f + __expf(-fabsf(x)));
      run += ls * (1.f / 16.f);
      cl[ii] = run;
    }
    tot[part * 64 + d] = run;
  }
  {
    const int i0 = tid >> 4, c0 = (tid & 15) * 8, i1 = (tid + 256) >> 4;
    const unsigned w0[4] = {vr0.x, vr0.y, vr0.z, vr0.w}, w1[4] = {vr1.x, vr1.y, vr1.z, vr1.w};
#pragma unroll
    for (int e = 0; e < 4; ++e) {
      VT[(c0 + 2 * e) * 40 + i0] = (u16)(w0[e] & 0xffffu); VT[(c0 + 2 * e + 1) * 40 + i0] = (u16)(w0[e] >> 16);
      VT[(c0 + 2 * e) * 40 + i1] = (u16)(w1[e] & 0xffffu); VT[(c0 + 2 * e + 1) * 40 + i1] = (u16)(w1[e] >> 16);
    }
  }
  __syncthreads();
  {
    float off = 0.f;
    if (part > 0) off += tot[d];
    if (part > 1) off += tot[64 + d];
    if (part > 2) off += tot[128 + d];
    u16* qg = (u16*)(c.ws + WS_QIN) + (size_t)idx * 2048;
#pragma unroll
    for (int ii = 0; ii < 8; ++ii) {
      const int i = part * 8 + ii;
      const float ex = __expf(cl[ii] + off);
      const u16 qi = f2bf(qv[ii] * ex), kp = f2bf(kv[ii] / ex);
      Qs[swz(i, d >> 3) + (d & 7)] = qi; KPs[swz(i, d >> 3) + (d & 7)] = kp; KPT[d * 40 + i] = kp;
      qg[(dir ? 31 - i : i) * 64 + d] = qi;
    }
    if (part == 0) ((float*)(c.ws + WS_AV))[(size_t)idx * 64 + d] = __expf(tot[d] + tot[64 + d] + tot[128 + d] + tot[192 + d]);
  }
  __syncthreads();
  f32x16 at;
#pragma unroll
  for (int r = 0; r < 16; ++r) at[r] = 0.f;
#pragma unroll
  for (int ks = 0; ks < 4; ++ks) {
    const bf16x8 a = *(const bf16x8*)(KPs + swz(ql, ks * 2 + hh));
    const bf16x8 b = *(const bf16x8*)(Qs + swz(ql, ks * 2 + hh));
    at = __builtin_amdgcn_mfma_f32_32x32x16_bf16(a, b, at, 0, 0, 0);
  }
#pragma unroll
  for (int r = 0; r < 16; ++r) if (crow(r, hh) > ql) at[r] = 0.f;
  f32x16 oi;
#pragma unroll
  for (int r = 0; r < 16; ++r) oi[r] = 0.f;
#pragma unroll
  for (int s = 0; s < 2; ++s) {
    u32x4 pw; pw[0] = pack2(at[8 * s + 0], at[8 * s + 1]); pw[1] = pack2(at[8 * s + 2], at[8 * s + 3]); pw[2] = pack2(at[8 * s + 4], at[8 * s + 5]); pw[3] = pack2(at[8 * s + 6], at[8 * s + 7]);
    const int ko = 16 * s + 4 * hh;
    const u32x2 lo = *(const u32x2*)(VT + (wid * 32 + ql) * 40 + ko), hi = *(const u32x2*)(VT + (wid * 32 + ql) * 40 + ko + 8);
    u32x4 vw; vw[0] = lo[0]; vw[1] = lo[1]; vw[2] = hi[0]; vw[3] = hi[1];
    oi = __builtin_amdgcn_mfma_f32_32x32x16_bf16(__builtin_bit_cast(bf16x8, vw), __builtin_bit_cast(bf16x8, pw), oi, 0, 0, 0);
  }
  {
    u16* ob = (u16*)(c.ws + (dir ? WS_OB : WS_OF)) + (size_t)(tok0 + (dir ? 31 - ql : ql)) * 512 + h * 128 + wid * 32 + 4 * hh;
#pragma unroll
    for (int g = 0; g < 4; ++g) *(uint2*)(ob + 8 * g) = make_uint2(pack2(oi[4 * g], oi[4 * g + 1]), pack2(oi[4 * g + 2], oi[4 * g + 3]));
  }
  u16* dsp = (u16*)(c.ws + WS_DS) + (size_t)idx * 8192;
  f32x16 dacc[2];
#pragma unroll
  for (int dt = 0; dt < 2; ++dt) {
#pragma unroll
    for (int r = 0; r < 16; ++r) dacc[dt][r] = 0.f;
#pragma unroll
    for (int ks = 0; ks < 2; ++ks) {
      const bf16x8 a = *(const bf16x8*)(VT + (wid * 32 + ql) * 40 + ks * 16 + 8 * hh);
      const bf16x8 b = *(const bf16x8*)(KPT + (dt * 32 + ql) * 40 + ks * 16 + 8 * hh);
      dacc[dt] = __builtin_amdgcn_mfma_f32_32x32x16_bf16(a, b, dacc[dt], 0, 0, 0);
    }
  }
  __syncthreads();
  u16* img = (u16*)c.lds + wid * 2048;
#pragma unroll
  for (int dt = 0; dt < 2; ++dt)
#pragma unroll
    for (int r = 0; r < 16; ++r) img[crow(r, hh) * 64 + dt * 32 + ql] = f2bf(dacc[dt][r]);
#pragma unroll
  for (int p = 0; p < 4; ++p) {
    const int row = p * 8 + (lane >> 3), ch = lane & 7;
    *(uint4*)(dsp + (size_t)(wid * 32 + row) * 64 + ch * 8) = *(const uint4*)(img + row * 64 + ch * 8);
  }
}

DI void step_mixers(const Ctx& c, int layer) {
  unsigned* ctr = (unsigned*)(c.ws + WS_CTR) + layer * 64;
  volatile int* slot = (volatile int*)(c.lds + LDS_BYTES);
  constexpr int TOTAL = 128 + 128 + 1536 + 256 + 256;
  bool first = true;
  for (;;) {
    int idx;
    if (first) { idx = (int)blockIdx.x; first = false; }
    else {
      __syncthreads();
      if (otid() == 0) *slot = (int)(atomicAdd(ctr, 1u) + gridDim.x);
      __syncthreads();
      idx = *slot;
    }
    if (idx >= TOTAL) break;
    int isg, a0, a1, a2, a3;
    if (idx < 128) { const int j = idx; isg = 0; a0 = 3; a1 = j >> 6; a2 = (j >> 3) & 7; a3 = j & 7; }
    else if (idx < 256) { const int j = idx - 128; isg = 0; a0 = 2; a1 = j >> 6; a2 = (j >> 3) & 7; a3 = j & 7; }
    else if (idx < 512) { const int j = idx - 256; isg = 0; a0 = 0; a1 = j >> 4; a2 = (j >> 1) & 7; a3 = j & 1; }
    else if (idx < 768) { const int j = idx - 512; isg = 0; a0 = 1; a1 = j >> 4; a2 = (j >> 1) & 7; a3 = j & 1; }
    else { const int j = idx - 768; isg = 1; a0 = j >> 3; a1 = (j >> 1) & 3; a2 = j & 1; a3 = 0; }
    if (isg) gla_g1_item(c, layer, a0, a1, a2); else attn_item(c, layer, a0, a1, a2, a3);
  }
}

DI void step_gla_scan(const Ctx& c, int layer) {
  const int tid = otid(), v16 = tid >> 4, dq = tid & 15;
  const u16* dS = (const u16*)(c.ws + WS_DS);
  const float* av = (const float*)(c.ws + WS_AV);
  u16* Sb = (u16*)(c.ws + WS_SB);
  for (int it = blockIdx.x; it < 1152; it += gridDim.x) {
    const int u = it >> 3, vb = it & 7, seq = u >> 3, h = (u >> 1) & 3, dir = u & 1, v = vb * 16 + v16;
    const int nch = seq < 16 ? 8 : 32, cu0 = seq < 16 ? seq * 8 : 128 + (seq - 16) * 32;
    float4 S = make_float4(0.f, 0.f, 0.f, 0.f);
    if (seq >= 16) {
      const float* sp = c.in[2] + ((((size_t)(seq - 16) * 4 + layer) * 2 + dir) * 4 + h) * 8192 + (size_t)(dq * 4) * 128 + v;
      S = make_float4(sp[0], sp[128], sp[256], sp[384]);
    }
#pragma unroll 8
    for (int cc = 0; cc < nch; ++cc) {
      const int cu = cu0 + (dir ? nch - 1 - cc : cc);
      const size_t idx = (size_t)((cu * 4 + h) * 2 + dir);
      *(uint2*)(Sb + idx * 8192 + v * 64 + dq * 4) = make_uint2(pack2(S.x, S.y), pack2(S.z, S.w));
      const uint2 dsr = *(const uint2*)(dS + idx * 8192 + v * 64 + dq * 4);
      const float4 ds = make_float4(bflo(dsr.x), bfhi(dsr.x), bflo(dsr.y), bfhi(dsr.y)), a = *(const float4*)(av + idx * 64 + dq * 4);
      S.x = a.x * (S.x + ds.x); S.y = a.y * (S.y + ds.y); S.z = a.z * (S.z + ds.z); S.w = a.w * (S.w + ds.w);
    }
    if (seq < 16) {
      float* sp = c.out + O_ST + ((((size_t)seq * 4 + layer) * 2 + dir) * 4 + h) * 8192 + (size_t)(dq * 4) * 128 + v;
      sp[0] = S.x; sp[128] = S.y; sp[256] = S.z; sp[384] = S.w;
    }
  }
}

DI void step_gla_out(const Ctx& c, int layer) {
  const int tid = otid(), lane = tid & 63, wid = tid >> 6, ql = lane & 31, hh = lane >> 5;
  const u16* Sb = (const u16*)(c.ws + WS_SB);
  const u16* qin = (const u16*)(c.ws + WS_QIN);
  const u16* of = (const u16*)(c.ws + WS_OF); const u16* ob = (const u16*)(c.ws + WS_OB);
  const u16* zb = (const u16*)(c.ws + WS_ZB);
  u16* att = (u16*)(c.ws + WS_ATT);
  float* red = (float*)c.lds;
  for (int it = blockIdx.x; it < 768; it += gridDim.x) {
    const int cu = it >> 2, h = it & 3, tok = cu * 32 + ql, vt = wid;
    f32x16 acc;
#pragma unroll
    for (int r = 0; r < 16; ++r) acc[r] = 0.f;
#pragma unroll
    for (int dir = 0; dir < 2; ++dir) {
      const size_t idx = (size_t)((cu * 4 + h) * 2 + dir);
#pragma unroll
      for (int ks = 0; ks < 4; ++ks) {
        const bf16x8 q = *(const bf16x8*)(qin + idx * 2048 + ql * 64 + ks * 16 + hh * 8);
        const bf16x8 a = *(const bf16x8*)(Sb + idx * 8192 + (vt * 32 + ql) * 64 + ks * 16 + hh * 8);
        acc = __builtin_amdgcn_mfma_f32_32x32x16_bf16(a, q, acc, 0, 0, 0);
      }
    }
    float ss = 0.f;
#pragma unroll
    for (int g = 0; g < 4; ++g) {
      const size_t o = (size_t)tok * 512 + h * 128 + vt * 32 + 8 * g + 4 * hh;
      const uint2 a = *(const uint2*)(of + o), b = *(const uint2*)(ob + o);
      acc[4 * g] += bflo(a.x) + bflo(b.x); acc[4 * g + 1] += bfhi(a.x) + bfhi(b.x); acc[4 * g + 2] += bflo(a.y) + bflo(b.y); acc[4 * g + 3] += bfhi(a.y) + bfhi(b.y);
      ss += acc[4 * g] * acc[4 * g] + acc[4 * g + 1] * acc[4 * g + 1] + acc[4 * g + 2] * acc[4 * g + 2] + acc[4 * g + 3] * acc[4 * g + 3];
    }
    ss += __shfl_xor(ss, 32);
    float4 gnq[4]; uint2 arq[4];
#pragma unroll
    for (int g = 0; g < 4; ++g) {
      const int v = vt * 32 + 8 * g + 4 * hh;
      gnq[g] = *(const float4*)(c.in[18] + layer * 128 + v);
      arq[g] = *(const uint2*)(zb + (size_t)tok * ZW + C_AR + h * 128 + v);
    }
    __syncthreads();
    if (hh == 0) red[wid * 32 + ql] = ss;
    __syncthreads();
    const float tot = red[ql] + red[32 + ql] + red[64 + ql] + red[96 + ql];
    const float rstd = rsqrtf(tot * (1.f / 128.f) + 1e-6f);
#pragma unroll
    for (int g = 0; g < 4; ++g) {
      const int v = vt * 32 + 8 * g + 4 * hh;
      const float4 gn = gnq[g];
      const uint2 ar = arq[g];
      const float y0 = acc[4 * g] * rstd * gn.x * siluf(bflo(ar.x)), y1 = acc[4 * g + 1] * rstd * gn.y * siluf(bfhi(ar.x));
      const float y2 = acc[4 * g + 2] * rstd * gn.z * siluf(bflo(ar.y)), y3 = acc[4 * g + 3] * rstd * gn.w * siluf(bfhi(ar.y));
      *(uint2*)(att + (size_t)tok * ATTW + h * 128 + v) = make_uint2(pack2(y0, y1), pack2(y2, y3));
    }
  }
}

__global__ void __launch_bounds__(256, 2) trunk_fwd(Params p) {
  __shared__ __attribute__((aligned(16))) unsigned char lds[LDS_BYTES + 32];
  volatile unsigned* st = (volatile unsigned*)(lds + LDS_BYTES + 16);
  unsigned* bar = (unsigned*)(p.ws + WS_BAR);
  unsigned xcc = 0;
  if (p.one) {
    if (threadIdx.x == 0) { st[0] = 0u; st[1] = 0u; }
    __syncthreads();
    xcc = xb_xcc_id();
    if (threadIdx.x == 0) (void)xb_add(&bar[XB_XCNT(xcc)], 1u);
  }
  for (int step0 = p.ph_lo; step0 < p.ph_hi; ++step0) {
    int step = step0; asm volatile("" : "+s"(step));
    Ctx c; c.in = p.in; c.out = p.out; c.ws = p.ws; c.lds = lds;
    if (step == 0) step_prep(c);
    else {
      const int layer = (step - 1) / NSPL, sub = (step - 1) % NSPL;
      switch (sub) {
        case 0: step_norm(c, layer, 0); break;
        case 1: step_gemm_in(c, layer); break;
        case 2: step_mixers(c, layer); break;
        case 3: step_gla_scan(c, layer); break;
        case 4: step_gla_out(c, layer); break;
        case 5: step_gemm_merge(c, layer); break;
        case 6: step_gemm_std<0>(c, layer); break;
        case 7: step_norm(c, layer, 1); break;
        case 8: step_gemm_std<1>(c, layer); break;
        default: step_gemm_std<2>(c, layer); break;
      }
    }
    if (step0 + 1 < p.ph_hi) {
      if (p.one == 2) cg::this_grid().sync();
      else xcd_barrier(bar, xcc, st);
    }
  }
}

extern "C" void kernel_launch(void* const* d_in, const int* in_sizes, int n_in, void* d_out, int out_size, void* d_ws, size_t ws_size, hipStream_t stream) {
  static int grid = 0;
  if (grid == 0) {
    if (n_in != 31 || ws_size < WS_END) { fprintf(stderr, "kernel_launch: unexpected n_in %d or ws_size %zu (< %zu)\n", n_in, ws_size, (size_t)WS_END); grid = -1; return; }
    int dev = 0, cus = 0, per_cu = 0;
    hipGetDevice(&dev);
    hipDeviceGetAttribute(&cus, hipDeviceAttributeMultiprocessorCount, dev);
    hipOccupancyMaxActiveBlocksPerMultiprocessor(&per_cu, (const void*)trunk_fwd, 256, 0);
    if (per_cu < 1) per_cu = 1;
    if (per_cu > 2) per_cu = 2;
    grid = cus * per_cu;
  }
  if (grid < 0) return;
  hipMemsetAsync((char*)d_ws + WS_BAR, 0, 65536, stream);
  Params p{};
  for (int i = 0; i < 31; ++i) p.in[i] = (const float*)d_in[i];
  p.out = (float*)d_out; p.ws = (unsigned char*)d_ws;
#if MK_ONE_LAUNCH
  p.ph_lo = 0; p.ph_hi = NSTEPS; p.one = 1;
  void* args[] = {&p};
  hipError_t e = hipLaunchCooperativeKernel((const void*)trunk_fwd, dim3(grid), dim3(256), args, 0, stream);
  if (e != hipSuccess) fprintf(stderr, "cooperative launch failed: %s (grid %d)\n", hipGetErrorString(e), grid);
#else
  for (int s = 0; s < NSTEPS; ++s) {
    p.ph_lo = s; p.ph_hi = s + 1; p.one = 0;
    hipLaunchKernelGGL(trunk_fwd, dim3(grid), dim3(256), 0, stream, p);
  }
#endif
}
```

```cpp
#include <hip/hip_runtime.h>
#include <hip/hip_bf16.h>
#include <hip/hip_cooperative_groups.h>
#include <cstdio>
#include <cstdint>
namespace cg = cooperative_groups;

#ifndef MK_ONE_LAUNCH
#define MK_ONE_LAUNCH 1
#endif

typedef unsigned short u16;
using bf16x8 = __attribute__((ext_vector_type(8))) short;
using s16x4 = __attribute__((ext_vector_type(4))) short;
using u32x4 = __attribute__((ext_vector_type(4))) unsigned;
using u32x2 = __attribute__((ext_vector_type(2))) unsigned;
using f32x4 = __attribute__((ext_vector_type(4))) float;
using f32x16 = __attribute__((ext_vector_type(16))) float;
#define DI __device__ __forceinline__

constexpr int DM = 1024, NTOK = 6144, NCTX = 4096, ZW = 7040, ATTW = 1536, HID = 4096;
constexpr int C_AQ = 0, C_AK = 256, C_AV = 512, C_AR = 1024, C_ALF = 1536, C_BQ = 1664, C_BK = 2176, C_BV = 2304,
              C_CQ = 2432, C_CK = 2944, C_CV = 3456, C_GA = 3968;
constexpr size_t O_ST = 6291456, O_SWK = 10485760, O_SWV = 12582912, O_NAK = 14680064, O_NAV = 23068672;

constexpr size_t WS_BAR = 0;
constexpr size_t WS_CTR = 16384;
constexpr size_t WS_MOD = 65536;
constexpr size_t WS_ROPE = WS_MOD + 294912;
constexpr size_t WS_WIN = 1u << 20;
constexpr size_t WS_WP = WS_WIN + (size_t)4 * ZW * 1024 * 2;
constexpr size_t WS_WO = WS_WP + (size_t)4 * 3 * 1024 * 512 * 2;
constexpr size_t WS_W1 = WS_WO + (size_t)4 * 1024 * 1024 * 2;
constexpr size_t WS_W2 = WS_W1 + (size_t)4 * 4096 * 1024 * 2;
constexpr size_t WS_H = WS_W2 + (size_t)4 * 4096 * 1024 * 2;
constexpr size_t WS_ZB = WS_H + (size_t)NTOK * 1024 * 2;
constexpr size_t WS_OF = WS_ZB + (size_t)NTOK * ZW * 2;
constexpr size_t WS_OB = WS_OF + (size_t)NTOK * 512 * 4;
constexpr size_t WS_ATT = WS_OB + (size_t)NTOK * 512 * 4;
constexpr size_t WS_MRG = WS_ATT + (size_t)NTOK * ATTW * 2;
constexpr size_t WS_U = WS_MRG + (size_t)NTOK * 1024 * 2;
constexpr size_t WS_DS = WS_U;
constexpr size_t WS_SB = WS_U + (size_t)NTOK * HID * 2;
constexpr size_t WS_QIN = WS_SB + (size_t)1536 * 8192 * 2;
constexpr size_t WS_AV = WS_QIN + (size_t)1536 * 2048 * 2;
constexpr size_t WS_KCS = WS_AV + (size_t)1536 * 64 * 4;
constexpr size_t WS_VCS = WS_KCS + (size_t)2 * 4 * 2 * 512 * 64 * 2;
constexpr size_t WS_KCN = WS_VCS + (size_t)2 * 4 * 2 * 512 * 64 * 2;
constexpr size_t WS_VCN = WS_KCN + (size_t)2 * 4 * 8 * 512 * 64 * 2;
constexpr size_t WS_VTS = WS_VCN + (size_t)2 * 4 * 8 * 512 * 64 * 2;
constexpr size_t WS_VTN = WS_VTS + (size_t)128 * NTOK * 2;
constexpr size_t WS_END = WS_VTN + (size_t)512 * NTOK * 2;

constexpr int LDS_BYTES = 73728;
constexpr int NSPL = 10;
constexpr int NSTEPS = 1 + NSPL * 4;

struct Params {
  const float* in[31];
  float* out;
  unsigned char* ws;
  int ph_lo, ph_hi, one, pad;
};

typedef __bf16 bf16x2_t __attribute__((ext_vector_type(2)));
typedef float f32x2_t __attribute__((ext_vector_type(2)));
DI u16 f2bf(float x) { return __builtin_bit_cast(u16, (__bf16)x); }
DI float bf2f(u16 v) { return __uint_as_float(((unsigned)v) << 16); }
DI unsigned pack2(float a, float b) { f32x2_t v = {a, b}; return __builtin_bit_cast(unsigned, __builtin_convertvector(v, bf16x2_t)); }
DI float bflo(unsigned u) { return __uint_as_float(u << 16); }
DI float bfhi(unsigned u) { return __uint_as_float(u & 0xffff0000u); }
DI int otid() { int t = threadIdx.x; asm volatile("" : "+v"(t)); return t; }
DI float sigmoidf(float x) { return 1.f / (1.f + __expf(-x)); }
DI float siluf(float x) { return x / (1.f + __expf(-x)); }

#define XB_TMO 128
#define XB_XCNT(j) (256 + 64 * (j))
#define XB_XSUB(j) (1280 + 64 * (j))
#define XB_XGEN(j) (2304 + 64 * (j))
#define XB_TOP 3328
#define XB_TOPGEN 3392
#define XCD_BAR_WORDS 3456
#define XB_SPIN_CAP (1u << 20)
DI unsigned xb_ld(unsigned* p) { return __hip_atomic_load(p, __ATOMIC_RELAXED, __HIP_MEMORY_SCOPE_AGENT); }
DI unsigned xb_add(unsigned* p, unsigned v) { return __hip_atomic_fetch_add(p, v, __ATOMIC_RELAXED, __HIP_MEMORY_SCOPE_AGENT); }
DI unsigned xb_xcc_id() { return (unsigned)__builtin_amdgcn_s_getreg((3 << 11) | 20) & 0xFu; }
#define XB_SPIN(cond, bar) do { unsigned _sp = 0; while (cond) { __builtin_amdgcn_s_sleep(1); \
    if ((++_sp & 255u) == 0u) { if (xb_ld(&(bar)[XB_TMO])) break; if (_sp > XB_SPIN_CAP) { atomicAdd(&(bar)[XB_TMO], 1u); break; } } } } while (0)

DI void xcd_barrier_complete(unsigned* bar, unsigned x, unsigned& nloc, unsigned& nx) {
  const unsigned G = gridDim.x;
  unsigned sum, cnt, mine, sp = 0u;
  for (;;) {
    sum = 0u; cnt = 0u; mine = 0u;
#pragma unroll
    for (unsigned j = 0; j < 16; ++j) { const unsigned c = xb_ld(&bar[XB_XCNT(j)]); sum += c; cnt += (c > 0u) ? 1u : 0u; mine = (j == x) ? c : mine; }
    if (sum == G) break;
    __builtin_amdgcn_s_sleep(1);
    if ((++sp & 255u) == 0u) { if (xb_ld(&bar[XB_TMO])) break; if (sp > XB_SPIN_CAP) { atomicAdd(&bar[XB_TMO], 1u); break; } }
  }
  nloc = mine > 0u ? mine : 1u; nx = cnt > 0u ? cnt : 1u;
}
DI void xcd_barrier(unsigned* bar, unsigned x, volatile unsigned* st) {
  asm volatile("s_waitcnt vmcnt(0)" ::: "memory");
  __syncthreads();
  if (threadIdx.x == 0) {
    __builtin_amdgcn_s_waitcnt(0);
    unsigned nloc = st[0], nx = st[1];
    if (nloc == 0u) { xcd_barrier_complete(bar, x, nloc, nx); st[0] = nloc; st[1] = nx; }
    const unsigned old = xb_add(&bar[XB_XSUB(x)], 1u);
    const unsigned gen = old / nloc;
    if (old + 1u == (gen + 1u) * nloc) {
      __builtin_amdgcn_fence(__ATOMIC_RELEASE, "agent");
      asm volatile("s_waitcnt vmcnt(0)" ::: "memory");
      const unsigned og = xb_add(&bar[XB_TOP], 1u);
      const unsigned tg = og / nx;
      if (og + 1u == (tg + 1u) * nx) xb_add(&bar[XB_TOPGEN], 1u);
      else XB_SPIN(xb_ld(&bar[XB_TOPGEN]) == tg, bar);
      __builtin_amdgcn_fence(__ATOMIC_ACQUIRE, "agent");
      xb_add(&bar[XB_XGEN(x)], 1u);
      asm volatile("s_waitcnt vmcnt(0)" ::: "memory");
    } else {
      XB_SPIN(xb_ld(&bar[XB_XGEN(x)]) == gen, bar);
      __builtin_amdgcn_fence(__ATOMIC_ACQUIRE, "agent");
      asm volatile("s_waitcnt vmcnt(0)" ::: "memory");
    }
  }
  __syncthreads();
}

struct Ctx {
  const float* const* in;
  float* out;
  unsigned char* ws;
  unsigned char* lds;
};
DI const float* xrow_src(const Ctx& c, int layer, int t) {
  if (layer == 0) return (t < NCTX) ? (c.in[0] + (size_t)t * DM) : (c.in[1] + (size_t)(t - NCTX) * DM);
  return c.out + (size_t)t * DM;
}
DI int cond_of(int t) { return t < NCTX ? 0 : 1 + ((t - NCTX) >> 10); }

DI void tr_tile(const float* __restrict__ src, int N, int k0, int n0, u16* __restrict__ dst, int ldd, int drow0, float* lds, int tid) {
  float4 v[8];
#pragma unroll
  for (int p = 0; p < 8; ++p) {
    const int kr = p * 32 + (tid >> 3), c4 = tid & 7;
    const f32x4 t4 = __builtin_nontemporal_load((const f32x4*)(src + (size_t)(k0 + kr) * N + n0 + c4 * 4));
    v[p] = make_float4(t4[0], t4[1], t4[2], t4[3]);
  }
  __syncthreads();
#pragma unroll
  for (int p = 0; p < 8; ++p) {
    const int kr = p * 32 + (tid >> 3), c4 = tid & 7;
    float* d = lds + kr * 33 + c4 * 4;
    d[0] = v[p].x; d[1] = v[p].y; d[2] = v[p].z; d[3] = v[p].w;
  }
  __syncthreads();
  const int n = tid >> 3, kc = tid & 7;
  u16* o = dst + (size_t)(drow0 + n) * ldd + k0 + kc * 32;
#pragma unroll
  for (int q = 0; q < 4; ++q) {
    unsigned w[4];
#pragma unroll
    for (int j = 0; j < 4; ++j) w[j] = pack2(lds[(kc * 32 + q * 8 + 2 * j) * 33 + n], lds[(kc * 32 + q * 8 + 2 * j + 1) * 33 + n]);
    *(uint4*)(o + q * 8) = make_uint4(w[0], w[1], w[2], w[3]);
  }
}

DI void step_prep(const Ctx& c) {
  const int tid = otid(), lane = tid & 63, wid = tid >> 6;
  float* lf = (float*)c.lds;
  constexpr int N_MOD = 4 * 96, N_ROPE = 1, N_PAD = 4 * 6, TR_PER_LAYER = 868 + 192 + 128 + 512 + 512, N_TR = 4 * TR_PER_LAYER;
  constexpr int N_CC = 2 * 4 * 10 * 8;
  constexpr int TOTAL = N_MOD + N_ROPE + N_PAD + N_CC + N_TR;
  for (int it = blockIdx.x; it < TOTAL; it += gridDim.x) {
    if (it < N_MOD) {
      const int l = it / 96, ch = it % 96;
      __syncthreads();
      for (int e = tid; e < 3 * 1024; e += 256) {
        const int ci = e >> 10, k = e & 1023;
        const float x = (ci == 0) ? c.in[8][k] : c.in[7][(ci - 1) * 1024 + k];
        lf[e] = siluf(x);
      }
      __syncthreads();
      const float* w = c.in[9] + (size_t)l * 1024 * 6144 + ch * 64 + lane;
      float a0 = 0.f, a1 = 0.f, a2 = 0.f;
      const int kb = wid * 256;
#pragma unroll 16
      for (int k = 0; k < 256; ++k) {
        const float wv = __builtin_nontemporal_load(w + (size_t)(kb + k) * 6144);
        a0 += lf[kb + k] * wv; a1 += lf[1024 + kb + k] * wv; a2 += lf[2048 + kb + k] * wv;
      }
      __syncthreads();
      lf[3072 + (wid * 3 + 0) * 64 + lane] = a0; lf[3072 + (wid * 3 + 1) * 64 + lane] = a1; lf[3072 + (wid * 3 + 2) * 64 + lane] = a2;
      __syncthreads();
      if (tid < 192) {
        const int ci = tid >> 6;
        float s = c.in[10][l * 6144 + ch * 64 + lane];
#pragma unroll
        for (int w2 = 0; w2 < 4; ++w2) s += lf[3072 + (w2 * 3 + ci) * 64 + lane];
        ((float*)(c.ws + WS_MOD))[(l * 3 + ci) * 6144 + ch * 64 + lane] = s;
      }
    } else if (it < N_MOD + N_ROPE) {
      float2* rt = (float2*)(c.ws + WS_ROPE);
      for (int e = tid; e < 1024; e += 256) {
        const int pos = e >> 4, f = e & 15;
        const float inv = exp2f(-(float)f * (13.287712379549449f / 16.f));
        float ang = (float)pos * inv;
        const float k = rintf(ang * 0.15915494309189535f);
        ang = fmaf(-k, 6.2831854820251465f, ang);
        ang = fmaf(-k, -1.7484555e-7f, ang);
        rt[e] = make_float2(cosf(ang), sinf(ang));
      }
    } else if (it < N_MOD + N_ROPE + N_PAD) {
      const int j = it - N_MOD - N_ROPE, l = j / 6, part = j % 6;
      u16* d = (u16*)(c.ws + WS_WIN) + ((size_t)l * ZW + 1568 + part * 16) * 1024;
      for (int e = tid; e < 16 * 1024 / 8; e += 256) ((uint4*)d)[e] = make_uint4(0, 0, 0, 0);
    } else if (it < N_MOD + N_ROPE + N_PAD + N_CC) {
      const int j = it - N_MOD - N_ROPE - N_PAD, kg = j & 7, hs = (j >> 3) % 10, bl = j / 80;
      const bool na = hs >= 2; const int h = na ? hs - 2 : hs, H = na ? 8 : 2;
      const float* ksrc = c.in[na ? 5 : 3] + (size_t)bl * 512 * H * 64 + h * 64;
      const float* vsrc = c.in[na ? 6 : 4] + (size_t)bl * 512 * H * 64 + h * 64;
      u16* kd = (u16*)(c.ws + (na ? WS_KCN : WS_KCS)) + ((size_t)bl * H + h) * 512 * 64;
      u16* vd = (u16*)(c.ws + (na ? WS_VCN : WS_VCS)) + ((size_t)bl * H + h) * 64 * 512;
      for (int e = tid; e < 64 * 16; e += 256) {
        const int key = kg * 64 + (e >> 4), d4 = (e & 15) * 4;
        const float4 kv = *(const float4*)(ksrc + (size_t)key * H * 64 + d4);
        *(uint2*)(kd + key * 64 + d4) = make_uint2(pack2(kv.x, kv.y), pack2(kv.z, kv.w));
      }
      for (int e = tid; e < 64 * 16; e += 256) {
        const int key = kg * 64 + (e & 63), d4 = (e >> 6) * 4;
        const float4 vv = *(const float4*)(vsrc + (size_t)key * H * 64 + d4);
        vd[(d4 + 0) * 512 + key] = f2bf(vv.x); vd[(d4 + 1) * 512 + key] = f2bf(vv.y); vd[(d4 + 2) * 512 + key] = f2bf(vv.z); vd[(d4 + 3) * 512 + key] = f2bf(vv.w);
      }
    } else {
      const int j = it - N_MOD - N_ROPE - N_PAD - N_CC, l = j / TR_PER_LAYER;
      int r = j % TR_PER_LAYER;
      if (r < 868) {
        const int kt = r / 217, nt = r % 217, n0 = nt * 32;
        tr_tile(c.in[13] + (size_t)l * 1024 * 6944, 6944, kt * 256, n0, (u16*)(c.ws + WS_WIN) + (size_t)l * ZW * 1024, 1024, n0 < 1568 ? n0 : n0 + 96, lf, tid);
      } else if (r < 868 + 192) {
        r -= 868; const int s = r / 64, q = r % 64, kt = q / 32, nt = q % 32;
        tr_tile(c.in[25 + s] + (size_t)l * 512 * 1024, 1024, kt * 256, nt * 32, (u16*)(c.ws + WS_WP) + (size_t)(l * 3 + s) * 1024 * 512, 512, nt * 32, lf, tid);
      } else if (r < 868 + 192 + 128) {
        r -= 868 + 192; const int kt = r / 32, nt = r % 32;
        tr_tile(c.in[28] + (size_t)l * 1024 * 1024, 1024, kt * 256, nt * 32, (u16*)(c.ws + WS_WO) + (size_t)l * 1024 * 1024, 1024, nt * 32, lf, tid);
      } else if (r < 868 + 192 + 128 + 512) {
        r -= 868 + 192 + 128; const int kt = r / 128, nt = r % 128;
        tr_tile(c.in[29] + (size_t)l * 1024 * 4096, 4096, kt * 256, nt * 32, (u16*)(c.ws + WS_W1) + (size_t)l * 4096 * 1024, 1024, nt * 32, lf, tid);
      } else {
        r -= 868 + 192 + 128 + 512; const int kt = r / 32, nt = r % 32;
        tr_tile(c.in[30] + (size_t)l * 4096 * 1024, 1024, kt * 256, nt * 32, (u16*)(c.ws + WS_W2) + (size_t)l * 1024 * 4096, 4096, nt * 32, lf, tid);
      }
    }
  }
}

DI void step_norm(const Ctx& c, int layer, int which) {
  const int tid = otid(), lane = tid & 63, wid = tid >> 6;
  const float* nw = c.in[which ? 12 : 11] + layer * 1024;
  u16* hb = (u16*)(c.ws + WS_H);
  for (int t = blockIdx.x * 4 + wid; t < NTOK; t += gridDim.x * 4) {
    const float* x = (which == 0) ? xrow_src(c, layer, t) : (c.out + (size_t)t * DM);
    const float* mod = (const float*)(c.ws + WS_MOD) + (layer * 3 + cond_of(t)) * 6144 + (which ? 3072 : 0);
    float4 v[4]; float ss = 0.f;
#pragma unroll
    for (int i = 0; i < 4; ++i) { v[i] = *(const float4*)(x + (lane + 64 * i) * 4); ss += v[i].x * v[i].x + v[i].y * v[i].y + v[i].z * v[i].z + v[i].w * v[i].w; }
#pragma unroll
    for (int o = 32; o >= 1; o >>= 1) ss += __shfl_xor(ss, o);
    const float rstd = rsqrtf(ss * (1.f / 1024.f) + 1e-6f);
    float4 gq[4], shq[4], scq[4];
#pragma unroll
    for (int i = 0; i < 4; ++i) { const int k = (lane + 64 * i) * 4; gq[i] = *(const float4*)(nw + k); shq[i] = *(const float4*)(mod + k); scq[i] = *(const float4*)(mod + 1024 + k); }
#pragma unroll
    for (int i = 0; i < 4; ++i) {
      const int k = (lane + 64 * i) * 4;
      const float4 g = gq[i], sh = shq[i], sc = scq[i];
      const float y0 = v[i].x * rstd * g.x * (1.f + sc.x) + sh.x, y1 = v[i].y * rstd * g.y * (1.f + sc.y) + sh.y;
      const float y2 = v[i].z * rstd * g.z * (1.f + sc.z) + sh.z, y3 = v[i].w * rstd * g.w * (1.f + sc.w) + sh.w;
      *(uint2*)(hb + (size_t)t * 1024 + k) = make_uint2(pack2(y0, y1), pack2(y2, y3));
    }
  }
}

DI int swz(int row, int chunk) { return row * 64 + ((chunk ^ ((row >> 1) & 7)) << 3); }
typedef __attribute__((address_space(3))) unsigned lds_u32;
template <int MI>
DI void gemm_core(const u16* __restrict__ A, int lda, const u16* __restrict__ Bt, int ldb, int K, f32x4 (&acc)[4][4], u16* lds, int tid,
                  bool prestaged = false, const u16* __restrict__ An = nullptr, const u16* __restrict__ Btn = nullptr) {
  const int lane = tid & 63, wid = tid >> 6, wr = wid >> 1, wc = wid & 1;
  const int lrow = tid >> 3, lch = tid & 7;
  const int sch = (lch ^ ((lrow >> 1) & 7)) * 8;
  const u16* ap = A + (size_t)lrow * lda + sch;
  const u16* bp = Bt + (size_t)lrow * ldb + sch;
  const size_t sa32 = (size_t)32 * lda, sb32 = (size_t)32 * ldb;
  lds_u32* l3 = (lds_u32*)(lds) + tid * 4;
#define STAGE(bufw, ko) do { \
    __builtin_amdgcn_global_load_lds((const unsigned*)(ap + (ko)), l3 + (bufw), 16, 0, 0); \
    __builtin_amdgcn_global_load_lds((const unsigned*)(ap + sa32 + (ko)), l3 + (bufw) + 1024, 16, 0, 0); \
    __builtin_amdgcn_global_load_lds((const unsigned*)(ap + 2 * sa32 + (ko)), l3 + (bufw) + 2048, 16, 0, 0); \
    if (MI == 4) __builtin_amdgcn_global_load_lds((const unsigned*)(ap + 3 * sa32 + (ko)), l3 + (bufw) + 3072, 16, 0, 0); \
    __builtin_amdgcn_global_load_lds((const unsigned*)(bp + (ko)), l3 + (bufw) + 4096, 16, 0, 0); \
    __builtin_amdgcn_global_load_lds((const unsigned*)(bp + sb32 + (ko)), l3 + (bufw) + 5120, 16, 0, 0); \
    __builtin_amdgcn_global_load_lds((const unsigned*)(bp + 2 * sb32 + (ko)), l3 + (bufw) + 6144, 16, 0, 0); \
    __builtin_amdgcn_global_load_lds((const unsigned*)(bp + 3 * sb32 + (ko)), l3 + (bufw) + 7168, 16, 0, 0); } while (0)
  const int fr = lane & 15, fq = lane >> 4;
  const int nkt = K >> 6;
  if (!prestaged) {
    __syncthreads();
    STAGE(0, 0);
  }
  for (int kt = 0; kt < nkt; ++kt) {
    asm volatile("s_waitcnt vmcnt(0)" ::: "memory");
    __builtin_amdgcn_s_barrier();
    if (kt + 1 < nkt) STAGE(((kt + 1) & 1) * 8192, (kt + 1) * 64);
    else if (An) {
      ap = An + (size_t)lrow * lda + sch; bp = Btn + (size_t)lrow * ldb + sch;
      STAGE(0, 0);
    }
    const u16* sa = lds + (kt & 1) * 16384;
    const u16* sb = sa + 8192;
#pragma unroll
    for (int ks = 0; ks < 2; ++ks) {
      bf16x8 af[4], bfr[4];
#pragma unroll
      for (int i = 0; i < MI; ++i) af[i] = *(const bf16x8*)(sa + swz(wr * (16 * MI) + i * 16 + fr, ks * 4 + fq));
#pragma unroll
      for (int j = 0; j < 4; ++j) bfr[j] = *(const bf16x8*)(sb + swz(wc * 64 + j * 16 + fr, ks * 4 + fq));
#pragma unroll
      for (int i = 0; i < MI; ++i)
#pragma unroll
        for (int j = 0; j < 4; ++j) acc[i][j] = __builtin_amdgcn_mfma_f32_16x16x32_bf16(bfr[j], af[i], acc[i][j], 0, 0, 0);
    }
  }
#undef STAGE
}
DI int swz32(int row, int chunk) { return row * 32 + ((chunk ^ ((0 - (row >> 2)) & 3)) << 3); }
template <int MI>
DI void gemm_core32(const u16* __restrict__ A, int lda, const u16* __restrict__ Bt, int ldb, int K, f32x4 (&acc)[MI][4], u16* lds, int tid,
                    bool prestaged, const u16* __restrict__ An, const u16* __restrict__ Btn, int& base) {
  constexpr int ABYTES = 32 * MI * 64, SLOT_U32 = (ABYTES + 8192) / 4, SLOT_U16 = (ABYTES + 8192) / 2, P = MI / 2 + 2;
  const int lane = tid & 63, wid = tid >> 6, wr = wid >> 1, wc = wid & 1;
  const int lrow = tid >> 2, lch = tid & 3;
  const int sch = (lch ^ ((0 - (lrow >> 2)) & 3)) * 8;
  const u16* ap = A + (size_t)lrow * lda + sch;
  const u16* bp = Bt + (size_t)lrow * ldb + sch;
  const size_t sa64 = (size_t)64 * lda, sb64 = (size_t)64 * ldb;
  lds_u32* l3 = (lds_u32*)(lds) + tid * 4;
#define STAGE32(slot, pa, pb, ko) do { lds_u32* _l = l3 + (slot) * SLOT_U32; \
    _Pragma("unroll") for (int _i = 0; _i < MI / 2; ++_i) __builtin_amdgcn_global_load_lds((const unsigned*)((pa) + _i * sa64 + (ko)), _l + _i * 1024, 16, 0, 0); \
    __builtin_amdgcn_global_load_lds((const unsigned*)((pb) + (ko)), _l + ABYTES / 4, 16, 0, 0); \
    __builtin_amdgcn_global_load_lds((const unsigned*)((pb) + sb64 + (ko)), _l + ABYTES / 4 + 1024, 16, 0, 0); } while (0)
  const int fr = lane & 15, fq = lane >> 4;
  const int nkt = K >> 5;
  const int aoff = swz32(wr * (16 * MI) + fr, fq), boff = ABYTES / 2 + swz32(wc * 64 + fr, fq);
  if (!prestaged) {
    base = 0;
    __syncthreads();
    STAGE32(0, ap, bp, 0);
    STAGE32(1, ap, bp, 32);
  }
  int slot = base;
  for (int kt = 0; kt < nkt; ++kt) {
    if (kt > 0 && (kt + 1 < nkt || An)) asm volatile("s_waitcnt vmcnt(%0)" :: "n"(P) : "memory");
    else asm volatile("s_waitcnt vmcnt(0)" ::: "memory");
    __builtin_amdgcn_s_barrier();
    const int s2 = (slot == 0) ? 2 : slot - 1;
    if (kt + 2 < nkt) STAGE32(s2, ap, bp, (kt + 2) * 32);
    else if (An) { const u16* apn = An + (size_t)lrow * lda + sch; const u16* bpn = Btn + (size_t)lrow * ldb + sch; STAGE32(s2, apn, bpn, (kt + 2 - nkt) * 32); }
    const u16* sa = lds + slot * SLOT_U16;
    bf16x8 af[MI], bfr[4];
#pragma unroll
    for (int i = 0; i < MI; ++i) af[i] = *(const bf16x8*)(sa + aoff + i * 16 * 32);
#pragma unroll
    for (int j = 0; j < 4; ++j) bfr[j] = *(const bf16x8*)(sa + boff + j * 16 * 32);
#pragma unroll
    for (int i = 0; i < MI; ++i)
#pragma unroll
      for (int j = 0; j < 4; ++j) acc[i][j] = __builtin_amdgcn_mfma_f32_16x16x32_bf16(bfr[j], af[i], acc[i][j], 0, 0, 0);
    slot = (slot == 2) ? 0 : slot + 1;
  }
  base = slot;
#undef STAGE32
}
template <int MI>
DI void zero_acc_n(f32x4 (&acc)[MI][4]) {
#pragma unroll
  for (int i = 0; i < MI; ++i)
#pragma unroll
    for (int j = 0; j < 4; ++j) acc[i][j] = f32x4{0.f, 0.f, 0.f, 0.f};
}
DI void zero_acc(f32x4 (&acc)[4][4]) {
#pragma unroll
  for (int i = 0; i < 4; ++i)
#pragma unroll
    for (int j = 0; j < 4; ++j) acc[i][j] = f32x4{0.f, 0.f, 0.f, 0.f};
}

DI bool sq_tile(int k, int nmt, int nnt, int& mt, int& nt) {
  if (gridDim.x != 512) { const int t = blockIdx.x + k * gridDim.x; mt = t % nmt; nt = t / nmt; return t < nmt * nnt; }
  const int x = blockIdx.x & 7, s = blockIdx.x >> 3, nmg = nmt >> 3;
  const int nst = nmg * ((nnt + 7) >> 3), last = ((nst + 7) >> 3) - 1;
  if (k == last && nst - 8 * last == 4) {
    const int st = k * 8 + (x & 3);
    if (s >= 32) return false;
    mt = (st % nmg) * 8 + (s & 7); nt = (st / nmg) * 8 + (x >> 2) * 4 + (s >> 3);
    return nt < nnt;
  }
  const int st = k * 8 + x;
  mt = (st % nmg) * 8 + (s & 7); nt = (st / nmg) * 8 + (s >> 3);
  return st < nst && nt < nnt;
}
DI int sq_rounds(int nmt, int nnt) { return (gridDim.x != 512) ? (nmt * nnt + gridDim.x - 1) / gridDim.x : ((nmt >> 3) * ((nnt + 7) >> 3) + 7) >> 3; }
DI void epi_put(u16* wl, int row, int j, int fq, unsigned lo, unsigned hi) {
  *(uint2*)(wl + row * 64 + (((j * 2 + (fq >> 1)) ^ (row & 7)) << 3) + (fq & 1) * 4) = make_uint2(lo, hi);
}
template <int MI>
DI void epi_flush(const u16* wl, u16* gbase, size_t ld, int lane) {
#pragma unroll
  for (int p = 0; p < MI * 2; ++p) {
    const int row = p * 8 + (lane >> 3), ch = lane & 7;
    const u32x4 v = *(const u32x4*)(wl + row * 64 + (ch << 3));
    __builtin_nontemporal_store(v, (u32x4*)(gbase + (size_t)row * ld + ((ch ^ (row & 7)) << 3)));
  }
}
DI void step_gemm_in(const Ctx& c, int layer) {
  const int tid = otid(), lane = tid & 63, wid = tid >> 6, wr = wid >> 1, wc = wid & 1, fr = lane & 15, fq = lane >> 4;
  const u16* hb = (const u16*)(c.ws + WS_H);
  const u16* wt = (const u16*)(c.ws + WS_WIN) + (size_t)layer * ZW * 1024;
  u16* zb = (u16*)(c.ws + WS_ZB);
  const float2* rope = (const float2*)(c.ws + WS_ROPE);
  constexpr int MI = 6, CH = 2, BM = 32 * MI, NMT = NTOK / BM, SLOT_U16 = (32 * MI * 64 + 8192) / 2;
  int rbase = 0;
  bool pre = false;
  for (int k = 0, nk = sq_rounds(NMT, 55); k < nk; ++k) {
    int mt, nt; if (!sq_tile(k, NMT, 55, mt, nt)) continue;
    const int m0 = mt * BM, n0 = nt * 128;
    int mtn = 0, ntn2 = 0; const bool hn = (k + 1 < nk) && sq_tile(k + 1, NMT, 55, mtn, ntn2);
    f32x4 acc[MI][4]; zero_acc_n<MI>(acc);
    gemm_core32<MI>(hb + (size_t)m0 * 1024, 1024, wt + (size_t)n0 * 1024, 1024, 1024, acc, (u16*)c.lds, tid, pre,
                    hn ? hb + (size_t)(mtn * BM) * 1024 : nullptr, hn ? wt + (size_t)(ntn2 * 128) * 1024 : nullptr, rbase);
    pre = hn;
    const int nb = n0 + wc * 64, jb = nb >> 6;
    __syncthreads();
    u16* wl = (u16*)c.lds + ((rbase == 0) ? 2 : rbase - 1) * SLOT_U16 + wid * 2048;
    int kind = 0;
    if (jb < 4) kind = 7; else if (jb < 26) kind = 0; else if (jb < 34) kind = 1; else if (jb < 36) kind = 2; else if (jb < 38) kind = 3;
    else if (jb < 46) kind = 4; else if (jb < 54) kind = 5; else if (jb < 62) kind = 6;
    const bool isnorm = (kind == 1 || kind == 2 || kind == 4 || kind == 5);
    const float* gwp = c.in[kind == 1 ? 19 : kind == 2 ? 20 : kind == 4 ? 22 : 23] + layer * 64;
    float4 gwv[4];
    if (isnorm) {
#pragma unroll
      for (int j = 0; j < 4; ++j) gwv[j] = *(const float4*)(gwp + j * 16 + fq * 4);
    }
#pragma unroll
    for (int ps = 0; ps < MI / CH; ++ps) {
#pragma unroll
    for (int ii = 0; ii < CH; ++ii) {
      const int i = ps * CH + ii;
      const int m = m0 + wr * (16 * MI) + i * 16 + fr;
      const bool lat = m >= NCTX;
      float v[4][4];
#pragma unroll
      for (int j = 0; j < 4; ++j)
#pragma unroll
        for (int r = 0; r < 4; ++r) v[j][r] = acc[i][j][r];
      if (isnorm) {
        float ss = 0.f;
#pragma unroll
        for (int j = 0; j < 4; ++j)
#pragma unroll
          for (int r = 0; r < 4; ++r) ss += v[j][r] * v[j][r];
        ss += __shfl_xor(ss, 16); ss += __shfl_xor(ss, 32);
        const float rstd = rsqrtf(ss * (1.f / 64.f) + 1e-6f);
#pragma unroll
        for (int j = 0; j < 4; ++j) {
          const float4 g = gwv[j];
          v[j][0] *= rstd * g.x; v[j][1] *= rstd * g.y; v[j][2] *= rstd * g.z; v[j][3] *= rstd * g.w;
        }
      }
      if (!lat && (kind == 2 || kind == 3 || kind == 5 || kind == 6)) {
        const int b = m >> 8, s = m & 255;
        float* o;
        if (kind == 2) o = c.out + O_SWK + ((size_t)((b * 4 + layer) * 256 + s)) * 128 + (jb - 34) * 64;
        else if (kind == 3) o = c.out + O_SWV + ((size_t)((b * 4 + layer) * 256 + s)) * 128 + (jb - 36) * 64;
        else if (kind == 5) o = c.out + O_NAK + ((size_t)((b * 4 + layer) * 256 + s)) * 512 + (jb - 46) * 64;
        else o = c.out + O_NAV + ((size_t)((b * 4 + layer) * 256 + s)) * 512 + (jb - 54) * 64;
#pragma unroll
        for (int j = 0; j < 4; ++j) *(float4*)(o + j * 16 + fq * 4) = make_float4(v[j][0], v[j][1], v[j][2], v[j][3]);
      }
      if (lat && (kind == 1 || kind == 2)) {
        const int nidx = (m - NCTX) & 1023, prow = nidx >> 6, pcol = nidx & 63;
#pragma unroll
        for (int r = 0; r < 4; ++r) {
          const float2 a = rope[prow * 16 + fq * 4 + r], b2 = rope[pcol * 16 + fq * 4 + r];
          const float x1 = v[0][r], x2 = v[1][r], y1 = v[2][r], y2 = v[3][r];
          v[0][r] = x1 * a.x - x2 * a.y; v[1][r] = x1 * a.y + x2 * a.x;
          v[2][r] = y1 * b2.x - y2 * b2.y; v[3][r] = y1 * b2.y + y2 * b2.x;
        }
      }
      if (kind == 3 || kind == 6) {
        u16* vt = (u16*)(c.ws + (kind == 3 ? WS_VTS : WS_VTN)) + (size_t)((kind == 3 ? jb - 36 : jb - 54) * 64) * NTOK + m;
#pragma unroll
        for (int j = 0; j < 4; ++j)
#pragma unroll
          for (int r = 0; r < 4; ++r) vt[(size_t)(j * 16 + fq * 4 + r) * NTOK] = f2bf(v[j][r]);
      }
      const float sc = (kind == 1 || kind == 4 || kind == 7) ? 0.125f : 1.f;
#pragma unroll
      for (int j = 0; j < 4; ++j) epi_put(wl, ii * 16 + fr, j, fq, pack2(v[j][0] * sc, v[j][1] * sc), pack2(v[j][2] * sc, v[j][3] * sc));
    }
    epi_flush<CH>(wl, zb + (size_t)(m0 + wr * (16 * MI) + ps * CH * 16) * ZW + nb, ZW, lane);
    }
  }
}

DI void step_gemm_merge(const Ctx& c, int layer) {
  const int tid = otid(), lane = tid & 63, wid = tid >> 6, wr = wid >> 1, wc = wid & 1, fr = lane & 15, fq = lane >> 4;
  const u16* att = (const u16*)(c.ws + WS_ATT);
  const u16* zb = (const u16*)(c.ws + WS_ZB);
  u16* mg = (u16*)(c.ws + WS_MRG);
  constexpr int MI = 3, BM = 32 * MI, NMT = NTOK / BM, NT = NMT * 8;
  bool pre = false;
  for (int k = 0, nk = sq_rounds(NMT, 8); k < nk; ++k) {
    int mt, nt; if (!sq_tile(k, NMT, 8, mt, nt)) continue;
    const int m0 = mt * BM, n0 = nt * 128;
    int mtn = 0, ntn2 = 0; const bool hn = (k + 1 < nk) && sq_tile(k + 1, NMT, 8, mtn, ntn2);
    f32x4 acc[4][4]; zero_acc(acc);
#pragma unroll 1
    for (int s = 0; s < 3; ++s) {
      const u16* wp = (const u16*)(c.ws + WS_WP);
      const bool hs = (s < 2) || hn;
      const u16* an = (s < 2) ? att + (size_t)m0 * ATTW + (s + 1) * 512 : att + (size_t)(mtn * BM) * ATTW;
      const u16* bn = (s < 2) ? wp + ((size_t)(layer * 3 + s + 1) * 1024 + n0) * 512 : wp + ((size_t)(layer * 3) * 1024 + ntn2 * 128) * 512;
      uint2 gq[MI][4], gnq[MI][4];
#pragma unroll
      for (int i = 0; i < MI; ++i) {
        const int m = m0 + wr * (16 * MI) + i * 16 + fr;
#pragma unroll
        for (int j = 0; j < 4; ++j) {
          const int n = n0 + wc * 64 + j * 16 + fq * 4;
          gq[i][j] = *(const uint2*)(zb + (size_t)m * ZW + C_GA + s * 1024 + n);
          gnq[i][j] = *(const uint2*)(zb + (size_t)m * ZW + C_GA + (s < 2 ? s + 1 : s) * 1024 + n);
        }
      }
      gemm_core<MI>(att + (size_t)m0 * ATTW + s * 512, ATTW, wp + ((size_t)(layer * 3 + s) * 1024 + n0) * 512, 512, 512, acc, (u16*)c.lds, tid, pre, hs ? an : nullptr, hs ? bn : nullptr);
      pre = hs;
#pragma unroll
      for (int i = 0; i < MI; ++i) {
#pragma unroll
        for (int j = 0; j < 4; ++j) {
          const uint2 g = gq[i][j];
          float f0 = fmaxf(sigmoidf(bflo(g.x)), 1e-6f), f1 = fmaxf(sigmoidf(bfhi(g.x)), 1e-6f), f2 = fmaxf(sigmoidf(bflo(g.y)), 1e-6f), f3 = fmaxf(sigmoidf(bfhi(g.y)), 1e-6f);
          if (s < 2) {
            const uint2 gn = gnq[i][j];
            f0 /= fmaxf(sigmoidf(bflo(gn.x)), 1e-6f); f1 /= fmaxf(sigmoidf(bfhi(gn.x)), 1e-6f); f2 /= fmaxf(sigmoidf(bflo(gn.y)), 1e-6f); f3 /= fmaxf(sigmoidf(bfhi(gn.y)), 1e-6f);
          }
          acc[i][j][0] *= f0; acc[i][j][1] *= f1; acc[i][j][2] *= f2; acc[i][j][3] *= f3;
        }
      }
    }
#pragma unroll
    for (int i = 0; i < MI; ++i) {
      const int m = m0 + wr * (16 * MI) + i * 16 + fr;
#pragma unroll
      for (int j = 0; j < 4; ++j) {
        const int n = n0 + wc * 64 + j * 16 + fq * 4;
        *(uint2*)(mg + (size_t)m * 1024 + n) = make_uint2(pack2(acc[i][j][0], acc[i][j][1]), pack2(acc[i][j][2], acc[i][j][3]));
      }
    }
  }
}

template <int MODE>
DI void step_gemm_std(const Ctx& c, int layer) {
  const int tid = otid(), lane = tid & 63, wid = tid >> 6, wr = wid >> 1, wc = wid & 1, fr = lane & 15, fq = lane >> 4;
  const u16* A = (const u16*)(c.ws + (MODE == 0 ? WS_MRG : MODE == 1 ? WS_H : WS_U));
  const int lda = (MODE == 2) ? HID : 1024, K = lda;
  const u16* Bt = (const u16*)(c.ws + (MODE == 0 ? WS_WO : MODE == 1 ? WS_W1 : WS_W2)) + (size_t)layer * 1024 * 4096 / (MODE == 0 ? 4 : 1);
  constexpr int ntn = (MODE == 1) ? 32 : 8;
  constexpr int MI = (MODE == 1) ? 6 : 3, CH = 2, BM = 32 * MI, NMT = NTOK / BM, SLOT_U16 = (32 * MI * 64 + 8192) / 2;
  int rbase = 0;
  bool pre = false;
  for (int k = 0, nk = sq_rounds(NMT, ntn); k < nk; ++k) {
    int mt, nt; if (!sq_tile(k, NMT, ntn, mt, nt)) continue;
    const int m0 = mt * BM, n0 = nt * 128;
    int mtn = 0, ntn2 = 0; const bool hn = (k + 1 < nk) && sq_tile(k + 1, NMT, ntn, mtn, ntn2);
    f32x4 acc[MI][4]; zero_acc_n<MI>(acc);
    if (MODE == 1) gemm_core32<MI>(A + (size_t)m0 * lda, lda, Bt + (size_t)n0 * K, K, K, acc, (u16*)c.lds, tid, pre,
                                   hn ? A + (size_t)(mtn * BM) * lda : nullptr, hn ? Bt + (size_t)(ntn2 * 128) * K : nullptr, rbase);
    else gemm_core<3>(A + (size_t)m0 * lda, lda, Bt + (size_t)n0 * K, K, K, (f32x4 (&)[4][4])acc, (u16*)c.lds, tid, pre,
                      hn ? A + (size_t)(mtn * BM) * lda : nullptr, hn ? Bt + (size_t)(ntn2 * 128) * K : nullptr);
    pre = hn;
    u16* wl = (MODE == 1) ? (u16*)c.lds + ((rbase == 0) ? 2 : rbase - 1) * SLOT_U16 + wid * 2048 : (u16*)c.lds + 16384 + wid * 4096;
    if (MODE == 1) __syncthreads();
#pragma unroll
    for (int i = 0; i < MI; ++i) {
      const int m = m0 + wr * (16 * MI) + i * 16 + fr;
      const float* gate = (const float*)(c.ws + WS_MOD) + (layer * 3 + cond_of(m)) * 6144 + (MODE == 0 ? 2048 : 5120);
#pragma unroll
      for (int j = 0; j < 4; ++j) {
        const int n = n0 + wc * 64 + j * 16 + fq * 4;
        if (MODE == 1) {
          float r0 = fmaxf(acc[i][j][0], 0.f), r1 = fmaxf(acc[i][j][1], 0.f), r2 = fmaxf(acc[i][j][2], 0.f), r3 = fmaxf(acc[i][j][3], 0.f);
          epi_put(wl, (i % CH) * 16 + fr, j, fq, pack2(r0 * r0, r1 * r1), pack2(r2 * r2, r3 * r3));
        } else {
          const float* xs = (MODE == 0) ? xrow_src(c, layer, m) : (c.out + (size_t)m * DM);
          const float4 xv = *(const float4*)(xs + n), g = *(const float4*)(gate + n);
          const f32x4 yv = {xv.x + g.x * acc[i][j][0], xv.y + g.y * acc[i][j][1], xv.z + g.z * acc[i][j][2], xv.w + g.w * acc[i][j][3]};
          __builtin_nontemporal_store(yv, (f32x4*)(c.out + (size_t)m * DM + n));
        }
      }
      if (MODE == 1 && (i % CH) == CH - 1) epi_flush<CH>(wl, (u16*)(c.ws + WS_U) + (size_t)(m0 + wr * (16 * MI) + (i / CH) * CH * 16) * HID + n0 + wc * 64, HID, lane);
    }
  }
}

DI int crow(int reg, int h) { return (reg & 3) + 8 * (reg >> 2) + 4 * h; }
DI void attn_item(const Ctx& c, int layer, int kind, int b, int hq, int qb) {
  const int tid = otid(), lane = tid & 63, wid = tid >> 6, ql = lane & 31, hh = lane >> 5;
  u16* Ks0 = (u16*)c.lds;
  float* rpb = (float*)(c.lds + 2 * 17408);
  const u16* zb = (const u16*)(c.ws + WS_ZB);
  u16* att = (u16*)(c.ws + WS_ATT);
  const bool isB = (kind == 0 || kind == 2);
  const int qcol = isB ? C_BQ + hq * 64 : C_CQ + hq * 64;
  const int kcol = isB ? C_BK + (hq >> 2) * 64 : C_CK + hq * 64;
  const int vcol = isB ? C_BV + (hq >> 2) * 64 : C_CV + hq * 64;
  const int outcol = isB ? 512 + hq * 64 : 1024 + hq * 64;
  int qtok0, ntiles, zrow0 = 0, tlo = 0, rs0 = 0;
  const u16 *kc = nullptr, *vc = nullptr;
  const int hk = isB ? (hq >> 2) : hq;
  const u16* vtl = (const u16*)(c.ws + (isB ? WS_VTS : WS_VTN)) + (size_t)(hk * 64) * NTOK;
  if (kind < 2) { qtok0 = b * 256 + qb * 128; ntiles = 4; zrow0 = b * 256; }
  else if (kind == 2) {
    qtok0 = NCTX + b * 1024 + qb * 128;
    tlo = (qb == 0) ? 2 : 0; const int thi = (qb == 7) ? 4 : 6; ntiles = 8 + thi - tlo;
    zrow0 = NCTX + b * 1024 + (qb - 1) * 128 + tlo * 64;
    kc = (const u16*)(c.ws + WS_KCS) + ((size_t)(b * 4 + layer) * 2 + hk) * 512 * 64; vc = (const u16*)(c.ws + WS_VCS) + ((size_t)(b * 4 + layer) * 2 + hk) * 64 * 512;
  } else {
    qtok0 = NCTX + b * 1024 + qb * 128;
    rs0 = min(max(2 * qb - 4, 0), 8); const int rs1 = min(max(2 * qb - 3, 0), 8); ntiles = 8 + rs1 + 8 - rs0;
    zrow0 = NCTX + b * 1024 + rs0 * 64;
    kc = (const u16*)(c.ws + WS_KCN) + ((size_t)(b * 4 + layer) * 8 + hk) * 512 * 64; vc = (const u16*)(c.ws + WS_VCN) + ((size_t)(b * 4 + layer) * 8 + hk) * 64 * 512;
  }
  const int ncache = (kind >= 2) ? 8 : 0;
  bf16x8 qf[4];
  {
    const u16* qp = zb + (size_t)(qtok0 + wid * 32 + ql) * ZW + qcol + hh * 8;
#pragma unroll
    for (int ks = 0; ks < 4; ++ks) qf[ks] = *(const bf16x8*)(qp + ks * 16);
  }
  __syncthreads();
  if (kind == 3) { for (int e = tid; e < 465; e += 256) rpb[e] = c.in[24][(size_t)(layer * 8 + hq) * 465 + e]; }
  float m_run, l_run;
  if (isB) { m_run = c.in[21][layer * 8 + hq]; l_run = (hh == 0) ? 1.f : 0.f; } else { m_run = -1e30f; l_run = 0.f; }
  f32x16 o0, o1;
#pragma unroll
  for (int r = 0; r < 16; ++r) { o0[r] = 0.f; o1[r] = 0.f; }
  const int qpos = qb * 128 + wid * 32 + ql;
  const int qr = 2 * qb + (wid >> 1), qc = (wid & 1) * 32 + ql;
  const int wrs = min(max(qr - 4, 0), 8), ccs = min(max(qc - 8, 0), 48);

  uint4 rk0, rk1, rv0, rv1;
  const int srow = tid >> 3, sc8 = tid & 7;
  auto prefetch = [&](int t) {
    const u16 *kp, *vp; size_t kst, vst;
    if (t < ncache) { kp = kc + (size_t)t * 64 * 64; kst = 64; vp = vc + t * 64; vst = 512; }
    else { const int row0 = zrow0 + (t - ncache) * 64; kp = zb + (size_t)row0 * ZW + kcol; kst = ZW; vp = vtl + row0; vst = NTOK; }
    rk0 = *(const uint4*)(kp + (size_t)srow * kst + sc8 * 8); rk1 = *(const uint4*)(kp + (size_t)(srow + 32) * kst + sc8 * 8);
    rv0 = *(const uint4*)(vp + (size_t)srow * vst + sc8 * 8); rv1 = *(const uint4*)(vp + (size_t)(srow + 32) * vst + sc8 * 8);
  };
  auto stash = [&](int t) {
    u16* Ks = Ks0 + (t & 1) * 8704; u16* Vt = Ks + 4096;
    *(uint4*)(Ks + swz(srow, sc8)) = rk0; *(uint4*)(Ks + swz(srow + 32, sc8)) = rk1;
    *(uint4*)(Vt + srow * 72 + sc8 * 8) = rv0; *(uint4*)(Vt + (srow + 32) * 72 + sc8 * 8) = rv1;
  };

  prefetch(0);
  stash(0);
  if (ntiles > 1) prefetch(1);
  for (int t = 0; t < ntiles; ++t) {
    __syncthreads();
    if (t + 1 < ntiles) { stash(t + 1); if (t + 2 < ntiles) prefetch(t + 2); }
    const u16* Ks = Ks0 + (t & 1) * 8704; const u16* Vt = Ks + 4096;
    bool skip = false;
    int kp0 = 0, kr = 0;
    const bool local = (t >= ncache) && kind >= 2;
    if (local && kind == 2) {
      kp0 = (qb - 1) * 128 + (tlo + t - ncache) * 64;
      const int qlo = qb * 128 + wid * 32;
      skip = (kp0 + 63 < qlo - 128) || (kp0 > qlo + 31 + 128);
    } else if (local && kind == 3) {
      kr = rs0 + (t - ncache);
      skip = (kr < wrs) || (kr >= wrs + 8);
    }
    if (!skip) {
      f32x16 s0, s1;
#pragma unroll
      for (int r = 0; r < 16; ++r) { s0[r] = 0.f; s1[r] = 0.f; }
#pragma unroll
      for (int ks = 0; ks < 4; ++ks) {
        const bf16x8 k0 = *(const bf16x8*)(Ks + swz(ql, ks * 2 + hh));
        const bf16x8 k1 = *(const bf16x8*)(Ks + swz(32 + ql, ks * 2 + hh));
        s0 = __builtin_amdgcn_mfma_f32_32x32x16_bf16(k0, qf[ks], s0, 0, 0, 0);
        s1 = __builtin_amdgcn_mfma_f32_32x32x16_bf16(k1, qf[ks], s1, 0, 0, 0);
      }
      if (local && kind == 2) {
#pragma unroll
        for (int r = 0; r < 16; ++r) {
          const int d0 = kp0 + crow(r, hh) - qpos, d1 = d0 + 32;
          if (d0 < -128 || d0 > 128) s0[r] = -1e30f;
          if (d1 < -128 || d1 > 128) s1[r] = -1e30f;
        }
      } else if (local && kind == 3) {
        const float* rp = rpb + (kr - qr + 7) * 31 + 15 - qc;
#pragma unroll
        for (int r = 0; r < 16; ++r) {
          const int k0c = crow(r, hh), k1c = k0c + 32;
          s0[r] = (k0c >= ccs && k0c < ccs + 16) ? s0[r] + rp[k0c] : -1e30f;
          s1[r] = (k1c >= ccs && k1c < ccs + 16) ? s1[r] + rp[k1c] : -1e30f;
        }
      }
      float mx = s0[0];
#pragma unroll
      for (int r = 1; r < 16; ++r) mx = fmaxf(mx, s0[r]);
#pragma unroll
      for (int r = 0; r < 16; ++r) mx = fmaxf(mx, s1[r]);
      mx = fmaxf(mx, __shfl_xor(mx, 32));
      const float m_new = fmaxf(m_run, mx);
      const float alpha = __expf(m_run - m_new);
      m_run = m_new;
      float rs = 0.f;
#pragma unroll
      for (int r = 0; r < 16; ++r) { s0[r] = __expf(s0[r] - m_new); s1[r] = __expf(s1[r] - m_new); rs += s0[r] + s1[r]; }
      l_run = l_run * alpha + rs;
#pragma unroll
      for (int r = 0; r < 16; ++r) { o0[r] *= alpha; o1[r] *= alpha; }
#pragma unroll
      for (int kt = 0; kt < 2; ++kt) {
#pragma unroll
        for (int s = 0; s < 2; ++s) {
          u32x4 pw;
          if (kt == 0) { pw[0] = pack2(s0[8 * s + 0], s0[8 * s + 1]); pw[1] = pack2(s0[8 * s + 2], s0[8 * s + 3]); pw[2] = pack2(s0[8 * s + 4], s0[8 * s + 5]); pw[3] = pack2(s0[8 * s + 6], s0[8 * s + 7]); }
          else { pw[0] = pack2(s1[8 * s + 0], s1[8 * s + 1]); pw[1] = pack2(s1[8 * s + 2], s1[8 * s + 3]); pw[2] = pack2(s1[8 * s + 4], s1[8 * s + 5]); pw[3] = pack2(s1[8 * s + 6], s1[8 * s + 7]); }
          const bf16x8 pf = __builtin_bit_cast(bf16x8, pw);
          const int ko = kt * 32 + 16 * s + 4 * hh;
          {
            const u32x2 lo = *(const u32x2*)(Vt + ql * 72 + ko), hi = *(const u32x2*)(Vt + ql * 72 + ko + 8);
            u32x4 vw; vw[0] = lo[0]; vw[1] = lo[1]; vw[2] = hi[0]; vw[3] = hi[1];
            o0 = __builtin_amdgcn_mfma_f32_32x32x16_bf16(__builtin_bit_cast(bf16x8, vw), pf, o0, 0, 0, 0);
          }
          {
            const u32x2 lo = *(const u32x2*)(Vt + (32 + ql) * 72 + ko), hi = *(const u32x2*)(Vt + (32 + ql) * 72 + ko + 8);
            u32x4 vw; vw[0] = lo[0]; vw[1] = lo[1]; vw[2] = hi[0]; vw[3] = hi[1];
            o1 = __builtin_amdgcn_mfma_f32_32x32x16_bf16(__builtin_bit_cast(bf16x8, vw), pf, o1, 0, 0, 0);
          }
        }
      }
    }
  }
  const float lt = l_run + __shfl_xor(l_run, 32);
  const float inv = 1.f / lt;
  u16* op = att + (size_t)(qtok0 + wid * 32 + ql) * ATTW + outcol + 4 * hh;
#pragma unroll
  for (int g = 0; g < 4; ++g) {
    *(uint2*)(op + 8 * g) = make_uint2(pack2(o0[4 * g] * inv, o0[4 * g + 1] * inv), pack2(o0[4 * g + 2] * inv, o0[4 * g + 3] * inv));
    *(uint2*)(op + 32 + 8 * g) = make_uint2(pack2(o1[4 * g] * inv, o1[4 * g + 1] * inv), pack2(o1[4 * g + 2] * inv, o1[4 * g + 3] * inv));
  }
}

DI void gla_g1_item(const Ctx& c, int layer, int cu, int h, int dir) {
  const int tid = otid(), lane = tid & 63, wid = tid >> 6, ql = lane & 31, hh = lane >> 5;
  u16* Qs = (u16*)c.lds;
  u16* KPs = Qs + 2048;
  u16* KPT = KPs + 2048;
  u16* VT = KPT + 64 * 40;
  float* al = (float*)(VT + 128 * 40);
  float* tot = al + 512;
  const u16* zb = (const u16*)(c.ws + WS_ZB);
  const int tok0 = cu * 32, idx = (cu * 4 + h) * 2 + dir;
  const int d = lane, part = wid;
  __syncthreads();
  if (tid < 128) {
    const int i = tid >> 2, c4 = tid & 3, tok = tok0 + (dir ? 31 - i : i);
    const uint2 av = *(const uint2*)(zb + (size_t)tok * ZW + C_ALF + dir * 16 + c4 * 4);
    *(float4*)(al + i * 16 + c4 * 4) = make_float4(bflo(av.x), bfhi(av.x), bflo(av.y), bfhi(av.y));
  }
  float qv[8], kv[8];
#pragma unroll
  for (int ii = 0; ii < 8; ++ii) {
    const int i = part * 8 + ii, tok = tok0 + (dir ? 31 - i : i);
    qv[ii] = bf2f(zb[(size_t)tok * ZW + C_AQ + h * 64 + d]);
    kv[ii] = bf2f(zb[(size_t)tok * ZW + C_AK + h * 64 + d]);
  }
  uint4 vr0, vr1;
  {
    const int q0 = tid, q1 = tid + 256;
    const int i0 = q0 >> 4, i1 = q1 >> 4;
    vr0 = *(const uint4*)(zb + (size_t)(tok0 + (dir ? 31 - i0 : i0)) * ZW + C_AV + h * 128 + (q0 & 15) * 8);
    vr1 = *(const uint4*)(zb + (size_t)(tok0 + (dir ? 31 - i1 : i1)) * ZW + C_AV + h * 128 + (q1 & 15) * 8);
  }
  float w2[16];
  {
    const float* wp = c.in[dir ? 16 : 14] + (size_t)layer * 16 * 256 + h * 64 + d;
#pragma unroll
    for (int r = 0; r < 16; ++r) w2[r] = wp[r * 256];
  }
  const float b2 = c.in[dir ? 17 : 15][layer * 256 + h * 64 + d];
  __syncthreads();
  float cl[8];
  {
    float run = 0.f;
#pragma unroll
    for (int ii = 0; ii < 8; ++ii) {
      const int i = part * 8 + ii;
      float x = b2;
#pragma unroll
      for (int r4 = 0; r4 < 4; ++r4) {
        const float4 a4 = *(const float4*)(al + i * 16 + r4 * 4);
        x += a4.x * w2[r4 * 4] + a4.y * w2[r4 * 4 + 1] + a4.z * w2[r4 * 4 + 2] + a4.w * w2[r4 * 4 + 3];
      }
      const float ls = fminf(x, 0.f) - __logf(1.f + __expf(-fabsf(x)));
      run += ls * (1.f / 16.f);
      cl[ii] = run;
    }
    tot[part * 64 + d] = run;
  }
  {
    const int i0 = tid >> 4, c0 = (tid & 15) * 8, i1 = (tid + 256) >> 4;
    const unsigned w0[4] = {vr0.x, vr0.y, vr0.z, vr0.w}, w1[4] = {vr1.x, vr1.y, vr1.z, vr1.w};
#pragma unroll
    for (int e = 0; e < 4; ++e) {
      VT[(c0 + 2 * e) * 40 + i0] = (u16)(w0[e] & 0xffffu); VT[(c0 + 2 * e + 1) * 40 + i0] = (u16)(w0[e] >> 16);
      VT[(c0 + 2 * e) * 40 + i1] = (u16)(w1[e] & 0xffffu); VT[(c0 + 2 * e + 1) * 40 + i1] = (u16)(w1[e] >> 16);
    }
  }
  __syncthreads();
  {
    float off = 0.f;
    if (part > 0) off += tot[d];
    if (part > 1) off += tot[64 + d];
    if (part > 2) off += tot[128 + d];
    u16* qg = (u16*)(c.ws + WS_QIN) + (size_t)idx * 2048;
#pragma unroll
    for (int ii = 0; ii < 8; ++ii) {
      const int i = part * 8 + ii;
      const float ex = __expf(cl[ii] + off);
      const u16 qi = f2bf(qv[ii] * ex), kp = f2bf(kv[ii] / ex);
      Qs[swz(i, d >> 3) + (d & 7)] = qi; KPs[swz(i, d >> 3) + (d & 7)] = kp; KPT[d * 40 + i] = kp;
      qg[(dir ? 31 - i : i) * 64 + d] = qi;
    }
    if (part == 0) ((float*)(c.ws + WS_AV))[(size_t)idx * 64 + d] = __expf(tot[d] + tot[64 + d] + tot[128 + d] + tot[192 + d]);
  }
  __syncthreads();
  f32x16 at;
#pragma unroll
  for (int r = 0; r < 16; ++r) at[r] = 0.f;
#pragma unroll
  for (int ks = 0; ks < 4; ++ks) {
    const bf16x8 a = *(const bf16x8*)(KPs + swz(ql, ks * 2 + hh));
    const bf16x8 b = *(const bf16x8*)(Qs + swz(ql, ks * 2 + hh));
    at = __builtin_amdgcn_mfma_f32_32x32x16_bf16(a, b, at, 0, 0, 0);
  }
#pragma unroll
  for (int r = 0; r < 16; ++r) if (crow(r, hh) > ql) at[r] = 0.f;
  f32x16 oi;
#pragma unroll
  for (int r = 0; r < 16; ++r) oi[r] = 0.f;
#pragma unroll
  for (int s = 0; s < 2; ++s) {
    u32x4 pw; pw[0] = pack2(at[8 * s + 0], at[8 * s + 1]); pw[1] = pack2(at[8 * s + 2], at[8 * s + 3]); pw[2] = pack2(at[8 * s + 4], at[8 * s + 5]); pw[3] = pack2(at[8 * s + 6], at[8 * s + 7]);
    const int ko = 16 * s + 4 * hh;
    const u32x2 lo = *(const u32x2*)(VT + (wid * 32 + ql) * 40 + ko), hi = *(const u32x2*)(VT + (wid * 32 + ql) * 40 + ko + 8);
    u32x4 vw; vw[0] = lo[0]; vw[1] = lo[1]; vw[2] = hi[0]; vw[3] = hi[1];
    oi = __builtin_amdgcn_mfma_f32_32x32x16_bf16(__builtin_bit_cast(bf16x8, vw), __builtin_bit_cast(bf16x8, pw), oi, 0, 0, 0);
  }
  {
    u16* ob = (u16*)(c.ws + (dir ? WS_OB : WS_OF)) + (size_t)(tok0 + (dir ? 31 - ql : ql)) * 512 + h * 128 + wid * 32 + 4 * hh;
#pragma unroll
    for (int g = 0; g < 4; ++g) *(uint2*)(ob + 8 * g) = make_uint2(pack2(oi[4 * g], oi[4 * g + 1]), pack2(oi[4 * g + 2], oi[4 * g + 3]));
  }
  u16* dsp = (u16*)(c.ws + WS_DS) + (size_t)idx * 8192;
  f32x16 dacc[2];
#pragma unroll
  for (int dt = 0; dt < 2; ++dt) {
#pragma unroll
    for (int r = 0; r < 16; ++r) dacc[dt][r] = 0.f;
#pragma unroll
    for (int ks = 0; ks < 2; ++ks) {
      const bf16x8 a = *(const bf16x8*)(VT + (wid * 32 + ql) * 40 + ks * 16 + 8 * hh);
      const bf16x8 b = *(const bf16x8*)(KPT + (dt * 32 + ql) * 40 + ks * 16 + 8 * hh);
      dacc[dt] = __builtin_amdgcn_mfma_f32_32x32x16_bf16(a, b, dacc[dt], 0, 0, 0);
    }
  }
  __syncthreads();
  u16* img = (u16*)c.lds + wid * 2048;
#pragma unroll
  for (int dt = 0; dt < 2; ++dt)
#pragma unroll
    for (int r = 0; r < 16; ++r) img[crow(r, hh) * 64 + dt * 32 + ql] = f2bf(dacc[dt][r]);
#pragma unroll
  for (int p = 0; p < 4; ++p) {
    const int row = p * 8 + (lane >> 3), ch = lane & 7;
    *(uint4*)(dsp + (size_t)(wid * 32 + row) * 64 + ch * 8) = *(const uint4*)(img + row * 64 + ch * 8);
  }
}

DI void step_mixers(const Ctx& c, int layer) {
  unsigned* ctr = (unsigned*)(c.ws + WS_CTR) + layer * 64;
  volatile int* slot = (volatile int*)(c.lds + LDS_BYTES);
  constexpr int TOTAL = 128 + 128 + 1536 + 256 + 256;
  bool first = true;
  for (;;) {
    int idx;
    if (first) { idx = (int)blockIdx.x; first = false; }
    else {
      __syncthreads();
      if (otid() == 0) *slot = (int)(atomicAdd(ctr, 1u) + gridDim.x);
      __syncthreads();
      idx = *slot;
    }
    if (idx >= TOTAL) break;
    int isg, a0, a1, a2, a3;
    if (idx < 128) { const int j = idx; isg = 0; a0 = 3; a1 = j >> 6; a2 = (j >> 3) & 7; a3 = j & 7; }
    else if (idx < 256) { const int j = idx - 128; isg = 0; a0 = 2; a1 = j >> 6; a2 = (j >> 3) & 7; a3 = j & 7; }
    else if (idx < 512) { const int j = idx - 256; isg = 0; a0 = 0; a1 = j >> 4; a2 = (j >> 1) & 7; a3 = j & 1; }
    else if (idx < 768) { const int j = idx - 512; isg = 0; a0 = 1; a1 = j >> 4; a2 = (j >> 1) & 7; a3 = j & 1; }
    else { const int j = idx - 768; isg = 1; a0 = j >> 3; a1 = (j >> 1) & 3; a2 = j & 1; a3 = 0; }
    if (isg) gla_g1_item(c, layer, a0, a1, a2); else attn_item(c, layer, a0, a1, a2, a3);
  }
}

DI void step_gla_scan(const Ctx& c, int layer) {
  const int tid = otid(), v16 = tid >> 4, dq = tid & 15;
  const u16* dS = (const u16*)(c.ws + WS_DS);
  const float* av = (const float*)(c.ws + WS_AV);
  u16* Sb = (u16*)(c.ws + WS_SB);
  for (int it = blockIdx.x; it < 1152; it += gridDim.x) {
    const int u = it >> 3, vb = it & 7, seq = u >> 3, h = (u >> 1) & 3, dir = u & 1, v = vb * 16 + v16;
    const int nch = seq < 16 ? 8 : 32, cu0 = seq < 16 ? seq * 8 : 128 + (seq - 16) * 32;
    float4 S = make_float4(0.f, 0.f, 0.f, 0.f);
    if (seq >= 16) {
      const float* sp = c.in[2] + ((((size_t)(seq - 16) * 4 + layer) * 2 + dir) * 4 + h) * 8192 + (size_t)(dq * 4) * 128 + v;
      S = make_float4(sp[0], sp[128], sp[256], sp[384]);
    }
#pragma unroll 8
    for (int cc = 0; cc < nch; ++cc) {
      const int cu = cu0 + (dir ? nch - 1 - cc : cc);
      const size_t idx = (size_t)((cu * 4 + h) * 2 + dir);
      *(uint2*)(Sb + idx * 8192 + v * 64 + dq * 4) = make_uint2(pack2(S.x, S.y), pack2(S.z, S.w));
      const uint2 dsr = *(const uint2*)(dS + idx * 8192 + v * 64 + dq * 4);
      const float4 ds = make_float4(bflo(dsr.x), bfhi(dsr.x), bflo(dsr.y), bfhi(dsr.y)), a = *(const float4*)(av + idx * 64 + dq * 4);
      S.x = a.x * (S.x + ds.x); S.y = a.y * (S.y + ds.y); S.z = a.z * (S.z + ds.z); S.w = a.w * (S.w + ds.w);
    }
    if (seq < 16) {
      float* sp = c.out + O_ST + ((((size_t)seq * 4 + layer) * 2 + dir) * 4 + h) * 8192 + (size_t)(dq * 4) * 128 + v;
      sp[0] = S.x; sp[128] = S.y; sp[256] = S.z; sp[384] = S.w;
    }
  }
}

DI void step_gla_out(const Ctx& c, int layer) {
  const int tid = otid(), lane = tid & 63, wid = tid >> 6, ql = lane & 31, hh = lane >> 5;
  const u16* Sb = (const u16*)(c.ws + WS_SB);
  const u16* qin = (const u16*)(c.ws + WS_QIN);
  const u16* of = (const u16*)(c.ws + WS_OF); const u16* ob = (const u16*)(c.ws + WS_OB);
  const u16* zb = (const u16*)(c.ws + WS_ZB);
  u16* att = (u16*)(c.ws + WS_ATT);
  float* red = (float*)c.lds;
  for (int it = blockIdx.x; it < 768; it += gridDim.x) {
    const int cu = it >> 2, h = it & 3, tok = cu * 32 + ql, vt = wid;
    f32x16 acc;
#pragma unroll
    for (int r = 0; r < 16; ++r) acc[r] = 0.f;
#pragma unroll
    for (int dir = 0; dir < 2; ++dir) {
      const size_t idx = (size_t)((cu * 4 + h) * 2 + dir);
#pragma unroll
      for (int ks = 0; ks < 4; ++ks) {
        const bf16x8 q = *(const bf16x8*)(qin + idx * 2048 + ql * 64 + ks * 16 + hh * 8);
        const bf16x8 a = *(const bf16x8*)(Sb + idx * 8192 + (vt * 32 + ql) * 64 + ks * 16 + hh * 8);
        acc = __builtin_amdgcn_mfma_f32_32x32x16_bf16(a, q, acc, 0, 0, 0);
      }
    }
    float ss = 0.f;
#pragma unroll
    for (int g = 0; g < 4; ++g) {
      const size_t o = (size_t)tok * 512 + h * 128 + vt * 32 + 8 * g + 4 * hh;
      const uint2 a = *(const uint2*)(of + o), b = *(const uint2*)(ob + o);
      acc[4 * g] += bflo(a.x) + bflo(b.x); acc[4 * g + 1] += bfhi(a.x) + bfhi(b.x); acc[4 * g + 2] += bflo(a.y) + bflo(b.y); acc[4 * g + 3] += bfhi(a.y) + bfhi(b.y);
      ss += acc[4 * g] * acc[4 * g] + acc[4 * g + 1] * acc[4 * g + 1] + acc[4 * g + 2] * acc[4 * g + 2] + acc[4 * g + 3] * acc[4 * g + 3];
    }
    ss += __shfl_xor(ss, 32);
    float4 gnq[4]; uint2 arq[4];
#pragma unroll
    for (int g = 0; g < 4; ++g) {
      const int v = vt * 32 + 8 * g + 4 * hh;
      gnq[g] = *(const float4*)(c.in[18] + layer * 128 + v);
      arq[g] = *(const uint2*)(zb + (size_t)tok * ZW + C_AR + h * 128 + v);
    }
    __syncthreads();
    if (hh == 0) red[wid * 32 + ql] = ss;
    __syncthreads();
    const float tot = red[ql] + red[32 + ql] + red[64 + ql] + red[96 + ql];
    const float rstd = rsqrtf(tot * (1.f / 128.f) + 1e-6f);
#pragma unroll
    for (int g = 0; g < 4; ++g) {
      const int v = vt * 32 + 8 * g + 4 * hh;
      const float4 gn = gnq[g];
      const uint2 ar = arq[g];
      const float y0 = acc[4 * g] * rstd * gn.x * siluf(bflo(ar.x)), y1 = acc[4 * g + 1] * rstd * gn.y * siluf(bfhi(ar.x));
      const float y2 = acc[4 * g + 2] * rstd * gn.z * siluf(bflo(ar.y)), y3 = acc[4 * g + 3] * rstd * gn.w * siluf(bfhi(ar.y));
      *(uint2*)(att + (size_t)tok * ATTW + h * 128 + v) = make_uint2(pack2(y0, y1), pack2(y2, y3));
    }
  }
}

__global__ void __launch_bounds__(256, 2) trunk_fwd(Params p) {
  __shared__ __attribute__((aligned(16))) unsigned char lds[LDS_BYTES + 32];
  volatile unsigned* st = (volatile unsigned*)(lds + LDS_BYTES + 16);
  unsigned* bar = (unsigned*)(p.ws + WS_BAR);
  unsigned xcc = 0;
  if (p.one) {
    if (threadIdx.x == 0) { st[0] = 0u; st[1] = 0u; }
    __syncthreads();
    xcc = xb_xcc_id();
    if (threadIdx.x == 0) (void)xb_add(&bar[XB_XCNT(xcc)], 1u);
  }
  for (int step0 = p.ph_lo; step0 < p.ph_hi; ++step0) {
    int step = step0; asm volatile("" : "+s"(step));
    Ctx c; c.in = p.in; c.out = p.out; c.ws = p.ws; c.lds = lds;
    if (step == 0) step_prep(c);
    else {
      const int layer = (step - 1) / NSPL, sub = (step - 1) % NSPL;
      switch (sub) {
        case 0: step_norm(c, layer, 0); break;
        case 1: step_gemm_in(c, layer); break;
        case 2: step_mixers(c, layer); break;
        case 3: step_gla_scan(c, layer); break;
        case 4: step_gla_out(c, layer); break;
        case 5: step_gemm_merge(c, layer); break;
        case 6: step_gemm_std<0>(c, layer); break;
        case 7: step_norm(c, layer, 1); break;
        case 8: step_gemm_std<1>(c, layer); break;
        default: step_gemm_std<2>(c, layer); break;
      }
    }
    if (step0 + 1 < p.ph_hi) {
      if (p.one == 2) cg::this_grid().sync();
      else xcd_barrier(bar, xcc, st);
    }
  }
}

extern "C" void kernel_launch(void* const* d_in, const int* in_sizes, int n_in, void* d_out, int out_size, void* d_ws, size_t ws_size, hipStream_t stream) {
  static int grid = 0;
  if (grid == 0) {
    if (n_in != 31 || ws_size < WS_END) { fprintf(stderr, "kernel_launch: unexpected n_in %d or ws_size %zu (< %zu)\n", n_in, ws_size, (size_t)WS_END); grid = -1; return; }
    int dev = 0, cus = 0, per_cu = 0;
    hipGetDevice(&dev);
    hipDeviceGetAttribute(&cus, hipDeviceAttributeMultiprocessorCount, dev);
    hipOccupancyMaxActiveBlocksPerMultiprocessor(&per_cu, (const void*)trunk_fwd, 256, 0);
    if (per_cu < 1) per_cu = 1;
    if (per_cu > 2) per_cu = 2;
    grid = cus * per_cu;
  }
  if (grid < 0) return;
  hipMemsetAsync((char*)d_ws + WS_BAR, 0, 65536, stream);
  Params p{};
  for (int i = 0; i < 31; ++i) p.in[i] = (const float*)d_in[i];
  p.out = (float*)d_out; p.ws = (unsigned char*)d_ws;
#if MK_ONE_LAUNCH
  p.ph_lo = 0; p.ph_hi = NSTEPS; p.one = 1;
  void* args[] = {&p};
  hipError_t e = hipLaunchCooperativeKernel((const void*)trunk_fwd, dim3(grid), dim3(256), args, 0, stream);
  if (e != hipSuccess) fprintf(stderr, "cooperative launch failed: %s (grid %d)\n", hipGetErrorString(e), grid);
#else
  for (int s = 0; s < NSTEPS; ++s) {
    p.ph_lo = s; p.ph_hi = s + 1; p.one = 0;
    hipLaunchKernelGGL(trunk_fwd, dim3(grid), dim3(256), 0, stream, p);
  }
#endif
}
```

```cpp
#include <hip/hip_runtime.h>
#include <hip/hip_bf16.h>
#include <hip/hip_cooperative_groups.h>
#include <cstdio>
#include <cstdint>
namespace cg = cooperative_groups;

#ifndef MK_ONE_LAUNCH
#define MK_ONE_LAUNCH 1
#endif

typedef unsigned short u16;
using bf16x8 = __attribute__((ext_vector_type(8))) short;
using s16x4 = __attribute__((ext_vector_type(4))) short;
using u32x4 = __attribute__((ext_vector_type(4))) unsigned;
using u32x2 = __attribute__((ext_vector_type(2))) unsigned;
using f32x4 = __attribute__((ext_vector_type(4))) float;
using f32x16 = __attribute__((ext_vector_type(16))) float;
#define DI __device__ __forceinline__

constexpr int DM = 1024, NTOK = 6144, NCTX = 4096, ZW = 7040, ATTW = 1536, HID = 4096;
constexpr int C_AQ = 0, C_AK = 256, C_AV = 512, C_AR = 1024, C_ALF = 1536, C_BQ = 1664, C_BK = 2176, C_BV = 2304,
              C_CQ = 2432, C_CK = 2944, C_CV = 3456, C_GA = 3968;
constexpr size_t O_ST = 6291456, O_SWK = 10485760, O_SWV = 12582912, O_NAK = 14680064, O_NAV = 23068672;

constexpr size_t WS_BAR = 0;
constexpr size_t WS_CTR = 16384;
constexpr size_t WS_MOD = 65536;
constexpr size_t WS_ROPE = WS_MOD + 294912;
constexpr size_t WS_WIN = 1u << 20;
constexpr size_t WS_WP = WS_WIN + (size_t)4 * ZW * 1024 * 2;
constexpr size_t WS_WO = WS_WP + (size_t)4 * 3 * 1024 * 512 * 2;
constexpr size_t WS_W1 = WS_WO + (size_t)4 * 1024 * 1024 * 2;
constexpr size_t WS_W2 = WS_W1 + (size_t)4 * 4096 * 1024 * 2;
constexpr size_t WS_H = WS_W2 + (size_t)4 * 4096 * 1024 * 2;
constexpr size_t WS_ZB = WS_H + (size_t)NTOK * 1024 * 2;
constexpr size_t WS_OF = WS_ZB + (size_t)NTOK * ZW * 2;
constexpr size_t WS_OB = WS_OF + (size_t)NTOK * 512 * 4;
constexpr size_t WS_ATT = WS_OB + (size_t)NTOK * 512 * 4;
constexpr size_t WS_MRG = WS_ATT + (size_t)NTOK * ATTW * 2;
constexpr size_t WS_U = WS_MRG + (size_t)NTOK * 1024 * 2;
constexpr size_t WS_DS = WS_U;
constexpr size_t WS_SB = WS_U + (size_t)NTOK * HID * 2;
constexpr size_t WS_QIN = WS_SB + (size_t)1536 * 8192 * 2;
constexpr size_t WS_AV = WS_QIN + (size_t)1536 * 2048 * 2;
constexpr size_t WS_KCS = WS_AV + (size_t)1536 * 64 * 4;
constexpr size_t WS_VCS = WS_KCS + (size_t)2 * 4 * 2 * 512 * 64 * 2;
constexpr size_t WS_KCN = WS_VCS + (size_t)2 * 4 * 2 * 512 * 64 * 2;
constexpr size_t WS_VCN = WS_KCN + (size_t)2 * 4 * 8 * 512 * 64 * 2;
constexpr size_t WS_VTS = WS_VCN + (size_t)2 * 4 * 8 * 512 * 64 * 2;
constexpr size_t WS_VTN = WS_VTS + (size_t)128 * NTOK * 2;
constexpr size_t WS_END = WS_VTN + (size_t)512 * NTOK * 2;

constexpr int LDS_BYTES = 73728;
constexpr int NSPL = 10;
constexpr int NSTEPS = 1 + NSPL * 4;

struct Params {
  const float* in[31];
  float* out;
  unsigned char* ws;
  int ph_lo, ph_hi, one, pad;
};

typedef __bf16 bf16x2_t __attribute__((ext_vector_type(2)));
typedef float f32x2_t __attribute__((ext_vector_type(2)));
DI u16 f2bf(float x) { return __builtin_bit_cast(u16, (__bf16)x); }
DI float bf2f(u16 v) { return __uint_as_float(((unsigned)v) << 16); }
DI unsigned pack2(float a, float b) { f32x2_t v = {a, b}; return __builtin_bit_cast(unsigned, __builtin_convertvector(v, bf16x2_t)); }
DI float bflo(unsigned u) { return __uint_as_float(u << 16); }
DI float bfhi(unsigned u) { return __uint_as_float(u & 0xffff0000u); }
DI int otid() { int t = threadIdx.x; asm volatile("" : "+v"(t)); return t; }
DI float sigmoidf(float x) { return 1.f / (1.f + __expf(-x)); }
DI float siluf(float x) { return x / (1.f + __expf(-x)); }

#define XB_TMO 128
#define XB_XCNT(j) (256 + 64 * (j))
#define XB_XSUB(j) (1280 + 64 * (j))
#define XB_XGEN(j) (2304 + 64 * (j))
#define XB_TOP 3328
#define XB_TOPGEN 3392
#define XCD_BAR_WORDS 3456
#define XB_SPIN_CAP (1u << 20)
DI unsigned xb_ld(unsigned* p) { return __hip_atomic_load(p, __ATOMIC_RELAXED, __HIP_MEMORY_SCOPE_AGENT); }
DI unsigned xb_add(unsigned* p, unsigned v) { return __hip_atomic_fetch_add(p, v, __ATOMIC_RELAXED, __HIP_MEMORY_SCOPE_AGENT); }
DI unsigned xb_xcc_id() { return (unsigned)__builtin_amdgcn_s_getreg((3 << 11) | 20) & 0xFu; }
#define XB_SPIN(cond, bar) do { unsigned _sp = 0; while (cond) { __builtin_amdgcn_s_sleep(1); \
    if ((++_sp & 255u) == 0u) { if (xb_ld(&(bar)[XB_TMO])) break; if (_sp > XB_SPIN_CAP) { atomicAdd(&(bar)[XB_TMO], 1u); break; } } } } while (0)

DI void xcd_barrier_complete(unsigned* bar, unsigned x, unsigned& nloc, unsigned& nx) {
  const unsigned G = gridDim.x;
  unsigned sum, cnt, mine, sp = 0u;
  for (;;) {
    sum = 0u; cnt = 0u; mine = 0u;
#pragma unroll
    for (unsigned j = 0; j < 16; ++j) { const unsigned c = xb_ld(&bar[XB_XCNT(j)]); sum += c; cnt += (c > 0u) ? 1u : 0u; mine = (j == x) ? c : mine; }
    if (sum == G) break;
    __builtin_amdgcn_s_sleep(1);
    if ((++sp & 255u) == 0u) { if (xb_ld(&bar[XB_TMO])) break; if (sp > XB_SPIN_CAP) { atomicAdd(&bar[XB_TMO], 1u); break; } }
  }
  nloc = mine > 0u ? mine : 1u; nx = cnt > 0u ? cnt : 1u;
}
DI void xcd_barrier(unsigned* bar, unsigned x, volatile unsigned* st) {
  asm volatile("s_waitcnt vmcnt(0)" ::: "memory");
  __syncthreads();
  if (threadIdx.x == 0) {
    __builtin_amdgcn_s_waitcnt(0);
    unsigned nloc = st[0], nx = st[1];
    if (nloc == 0u) { xcd_barrier_complete(bar, x, nloc, nx); st[0] = nloc; st[1] = nx; }
    const unsigned old = xb_add(&bar[XB_XSUB(x)], 1u);
    const unsigned gen = old / nloc;
    if (old + 1u == (gen + 1u) * nloc) {
      __builtin_amdgcn_fence(__ATOMIC_RELEASE, "agent");
      asm volatile("s_waitcnt vmcnt(0)" ::: "memory");
      const unsigned og = xb_add(&bar[XB_TOP], 1u);
      const unsigned tg = og / nx;
      if (og + 1u == (tg + 1u) * nx) xb_add(&bar[XB_TOPGEN], 1u);
      else XB_SPIN(xb_ld(&bar[XB_TOPGEN]) == tg, bar);
      __builtin_amdgcn_fence(__ATOMIC_ACQUIRE, "agent");
      xb_add(&bar[XB_XGEN(x)], 1u);
      asm volatile("s_waitcnt vmcnt(0)" ::: "memory");
    } else {
      XB_SPIN(xb_ld(&bar[XB_XGEN(x)]) == gen, bar);
      __builtin_amdgcn_fence(__ATOMIC_ACQUIRE, "agent");
      asm volatile("s_waitcnt vmcnt(0)" ::: "memory");
    }
  }
  __syncthreads();
}

struct Ctx {
  const float* const* in;
  float* out;
  unsigned char* ws;
  unsigned char* lds;
};
DI const float* xrow_src(const Ctx& c, int layer, int t) {
  if (layer == 0) return (t < NCTX) ? (c.in[0] + (size_t)t * DM) : (c.in[1] + (size_t)(t - NCTX) * DM);
  return c.out + (size_t)t * DM;
}
DI int cond_of(int t) { return t < NCTX ? 0 : 1 + ((t - NCTX) >> 10); }

DI void tr_tile(const float* __restrict__ src, int N, int k0, int n0, u16* __restrict__ dst, int ldd, int drow0, float* lds, int tid) {
  float4 v[8];
#pragma unroll
  for (int p = 0; p < 8; ++p) {
    const int kr = p * 32 + (tid >> 3), c4 = tid & 7;
    const f32x4 t4 = __builtin_nontemporal_load((const f32x4*)(src + (size_t)(k0 + kr) * N + n0 + c4 * 4));
    v[p] = make_float4(t4[0], t4[1], t4[2], t4[3]);
  }
  __syncthreads();
#pragma unroll
  for (int p = 0; p < 8; ++p) {
    const int kr = p * 32 + (tid >> 3), c4 = tid & 7;
    float* d = lds + kr * 33 + c4 * 4;
    d[0] = v[p].x; d[1] = v[p].y; d[2] = v[p].z; d[3] = v[p].w;
  }
  __syncthreads();
  const int n = tid >> 3, kc = tid & 7;
  u16* o = dst + (size_t)(drow0 + n) * ldd + k0 + kc * 32;
#pragma unroll
  for (int q = 0; q < 4; ++q) {
    unsigned w[4];
#pragma unroll
    for (int j = 0; j < 4; ++j) w[j] = pack2(lds[(kc * 32 + q * 8 + 2 * j) * 33 + n], lds[(kc * 32 + q * 8 + 2 * j + 1) * 33 + n]);
    *(uint4*)(o + q * 8) = make_uint4(w[0], w[1], w[2], w[3]);
  }
}

DI void step_prep(const Ctx& c) {
  const int tid = otid(), lane = tid & 63, wid = tid >> 6;
  float* lf = (float*)c.lds;
  constexpr int N_MOD = 4 * 96, N_ROPE = 1, N_PAD = 4 * 6, TR_PER_LAYER = 868 + 192 + 128 + 512 + 512, N_TR = 4 * TR_PER_LAYER;
  constexpr int N_CC = 2 * 4 * 10 * 8;
  constexpr int TOTAL = N_MOD + N_ROPE + N_PAD + N_CC + N_TR;
  for (int it = blockIdx.x; it < TOTAL; it += gridDim.x) {
    if (it < N_MOD) {
      const int l = it / 96, ch = it % 96;
      __syncthreads();
      for (int e = tid; e < 3 * 1024; e += 256) {
        const int ci = e >> 10, k = e & 1023;
        const float x = (ci == 0) ? c.in[8][k] : c.in[7][(ci - 1) * 1024 + k];
        lf[e] = siluf(x);
      }
      __syncthreads();
      const float* w = c.in[9] + (size_t)l * 1024 * 6144 + ch * 64 + lane;
      float a0 = 0.f, a1 = 0.f, a2 = 0.f;
      const int kb = wid * 256;
#pragma unroll 16
      for (int k = 0; k < 256; ++k) {
        const float wv = __builtin_nontemporal_load(w + (size_t)(kb + k) * 6144);
        a0 += lf[kb + k] * wv; a1 += lf[1024 + kb + k] * wv; a2 += lf[2048 + kb + k] * wv;
      }
      __syncthreads();
      lf[3072 + (wid * 3 + 0) * 64 + lane] = a0; lf[3072 + (wid * 3 + 1) * 64 + lane] = a1; lf[3072 + (wid * 3 + 2) * 64 + lane] = a2;
      __syncthreads();
      if (tid < 192) {
        const int ci = tid >> 6;
        float s = c.in[10][l * 6144 + ch * 64 + lane];
#pragma unroll
        for (int w2 = 0; w2 < 4; ++w2) s += lf[3072 + (w2 * 3 + ci) * 64 + lane];
        ((float*)(c.ws + WS_MOD))[(l * 3 + ci) * 6144 + ch * 64 + lane] = s;
      }
    } else if (it < N_MOD + N_ROPE) {
      float2* rt = (float2*)(c.ws + WS_ROPE);
      for (int e = tid; e < 1024; e += 256) {
        const int pos = e >> 4, f = e & 15;
        const float inv = exp2f(-(float)f * (13.287712379549449f / 16.f));
        float ang = (float)pos * inv;
        const float k = rintf(ang * 0.15915494309189535f);
        ang = fmaf(-k, 6.2831854820251465f, ang);
        ang = fmaf(-k, -1.7484555e-7f, ang);
        rt[e] = make_float2(cosf(ang), sinf(ang));
      }
    } else if (it < N_MOD + N_ROPE + N_PAD) {
      const int j = it - N_MOD - N_ROPE, l = j / 6, part = j % 6;
      u16* d = (u16*)(c.ws + WS_WIN) + ((size_t)l * ZW + 1568 + part * 16) * 1024;
      for (int e = tid; e < 16 * 1024 / 8; e += 256) ((uint4*)d)[e] = make_uint4(0, 0, 0, 0);
    } else if (it < N_MOD + N_ROPE + N_PAD + N_CC) {
      const int j = it - N_MOD - N_ROPE - N_PAD, kg = j & 7, hs = (j >> 3) % 10, bl = j / 80;
      const bool na = hs >= 2; const int h = na ? hs - 2 : hs, H = na ? 8 : 2;
      const float* ksrc = c.in[na ? 5 : 3] + (size_t)bl * 512 * H * 64 + h * 64;
      const float* vsrc = c.in[na ? 6 : 4] + (size_t)bl * 512 * H * 64 + h * 64;
      u16* kd = (u16*)(c.ws + (na ? WS_KCN : WS_KCS)) + ((size_t)bl * H + h) * 512 * 64;
      u16* vd = (u16*)(c.ws + (na ? WS_VCN : WS_VCS)) + ((size_t)bl * H + h) * 64 * 512;
      for (int e = tid; e < 64 * 16; e += 256) {
        const int key = kg * 64 + (e >> 4), d4 = (e & 15) * 4;
        const float4 kv = *(const float4*)(ksrc + (size_t)key * H * 64 + d4);
        *(uint2*)(kd + key * 64 + d4) = make_uint2(pack2(kv.x, kv.y), pack2(kv.z, kv.w));
      }
      for (int e = tid; e < 64 * 16; e += 256) {
        const int key = kg * 64 + (e & 63), d4 = (e >> 6) * 4;
        const float4 vv = *(const float4*)(vsrc + (size_t)key * H * 64 + d4);
        vd[(d4 + 0) * 512 + key] = f2bf(vv.x); vd[(d4 + 1) * 512 + key] = f2bf(vv.y); vd[(d4 + 2) * 512 + key] = f2bf(vv.z); vd[(d4 + 3) * 512 + key] = f2bf(vv.w);
      }
    } else {
      const int j = it - N_MOD - N_ROPE - N_PAD - N_CC, l = j / TR_PER_LAYER;
      int r = j % TR_PER_LAYER;
      if (r < 868) {
        const int kt = r / 217, nt = r % 217, n0 = nt * 32;
        tr_tile(c.in[13] + (size_t)l * 1024 * 6944, 6944, kt * 256, n0, (u16*)(c.ws + WS_WIN) + (size_t)l * ZW * 1024, 1024, n0 < 1568 ? n0 : n0 + 96, lf, tid);
      } else if (r < 868 + 192) {
        r -= 868; const int s = r / 64, q = r % 64, kt = q / 32, nt = q % 32;
        tr_tile(c.in[25 + s] + (size_t)l * 512 * 1024, 1024, kt * 256, nt * 32, (u16*)(c.ws + WS_WP) + (size_t)(l * 3 + s) * 1024 * 512, 512, nt * 32, lf, tid);
      } else if (r < 868 + 192 + 128) {
        r -= 868 + 192; const int kt = r / 32, nt = r % 32;
        tr_tile(c.in[28] + (size_t)l * 1024 * 1024, 1024, kt * 256, nt * 32, (u16*)(c.ws + WS_WO) + (size_t)l * 1024 * 1024, 1024, nt * 32, lf, tid);
      } else if (r < 868 + 192 + 128 + 512) {
        r -= 868 + 192 + 128; const int kt = r / 128, nt = r % 128;
        tr_tile(c.in[29] + (size_t)l * 1024 * 4096, 4096, kt * 256, nt * 32, (u16*)(c.ws + WS_W1) + (size_t)l * 4096 * 1024, 1024, nt * 32, lf, tid);
      } else {
        r -= 868 + 192 + 128 + 512; const int kt = r / 32, nt = r % 32;
        tr_tile(c.in[30] + (size_t)l * 4096 * 1024, 1024, kt * 256, nt * 32, (u16*)(c.ws + WS_W2) + (size_t)l * 1024 * 4096, 4096, nt * 32, lf, tid);
      }
    }
  }
}

DI void step_norm(const Ctx& c, int layer, int which) {
  const int tid = otid(), lane = tid & 63, wid = tid >> 6;
  const float* nw = c.in[which ? 12 : 11] + layer * 1024;
  u16* hb = (u16*)(c.ws + WS_H);
  for (int t = blockIdx.x * 4 + wid; t < NTOK; t += gridDim.x * 4) {
    const float* x = (which == 0) ? xrow_src(c, layer, t) : (c.out + (size_t)t * DM);
    const float* mod = (const float*)(c.ws + WS_MOD) + (layer * 3 + cond_of(t)) * 6144 + (which ? 3072 : 0);
    float4 v[4]; float ss = 0.f;
#pragma unroll
    for (int i = 0; i < 4; ++i) { v[i] = *(const float4*)(x + (lane + 64 * i) * 4); ss += v[i].x * v[i].x + v[i].y * v[i].y + v[i].z * v[i].z + v[i].w * v[i].w; }
#pragma unroll
    for (int o = 32; o >= 1; o >>= 1) ss += __shfl_xor(ss, o);
    const float rstd = rsqrtf(ss * (1.f / 1024.f) + 1e-6f);
    float4 gq[4], shq[4], scq[4];
#pragma unroll
    for (int i = 0; i < 4; ++i) { const int k = (lane + 64 * i) * 4; gq[i] = *(const float4*)(nw + k); shq[i] = *(const float4*)(mod + k); scq[i] = *(const float4*)(mod + 1024 + k); }
#pragma unroll
    for (int i = 0; i < 4; ++i) {
      const int k = (lane + 64 * i) * 4;
      const float4 g = gq[i], sh = shq[i], sc = scq[i];
      const float y0 = v[i].x * rstd * g.x * (1.f + sc.x) + sh.x, y1 = v[i].y * rstd * g.y * (1.f + sc.y) + sh.y;
      const float y2 = v[i].z * rstd * g.z * (1.f + sc.z) + sh.z, y3 = v[i].w * rstd * g.w * (1.f + sc.w) + sh.w;
      *(uint2*)(hb + (size_t)t * 1024 + k) = make_uint2(pack2(y0, y1), pack2(y2, y3));
    }
  }
}

DI int swz(int row, int chunk) { return row * 64 + ((chunk ^ ((row >> 1) & 7)) << 3); }
typedef __attribute__((address_space(3))) unsigned lds_u32;
template <int MI>
DI void gemm_core(const u16* __restrict__ A, int lda, const u16* __restrict__ Bt, int ldb, int K, f32x4 (&acc)[4][4], u16* lds, int tid,
                  bool prestaged = false, const u16* __restrict__ An = nullptr, const u16* __restrict__ Btn = nullptr) {
  const int lane = tid & 63, wid = tid >> 6, wr = wid >> 1, wc = wid & 1;
  const int lrow = tid >> 3, lch = tid & 7;
  const int sch = (lch ^ ((lrow >> 1) & 7)) * 8;
  const u16* ap = A + (size_t)lrow * lda + sch;
  const u16* bp = Bt + (size_t)lrow * ldb + sch;
  const size_t sa32 = (size_t)32 * lda, sb32 = (size_t)32 * ldb;
  lds_u32* l3 = (lds_u32*)(lds) + tid * 4;
#define STAGE(bufw, ko) do { \
    __builtin_amdgcn_global_load_lds((const unsigned*)(ap + (ko)), l3 + (bufw), 16, 0, 0); \
    __builtin_amdgcn_global_load_lds((const unsigned*)(ap + sa32 + (ko)), l3 + (bufw) + 1024, 16, 0, 0); \
    __builtin_amdgcn_global_load_lds((const unsigned*)(ap + 2 * sa32 + (ko)), l3 + (bufw) + 2048, 16, 0, 0); \
    if (MI == 4) __builtin_amdgcn_global_load_lds((const unsigned*)(ap + 3 * sa32 + (ko)), l3 + (bufw) + 3072, 16, 0, 0); \
    __builtin_amdgcn_global_load_lds((const unsigned*)(bp + (ko)), l3 + (bufw) + 4096, 16, 0, 0); \
    __builtin_amdgcn_global_load_lds((const unsigned*)(bp + sb32 + (ko)), l3 + (bufw) + 5120, 16, 0, 0); \
    __builtin_amdgcn_global_load_lds((const unsigned*)(bp + 2 * sb32 + (ko)), l3 + (bufw) + 6144, 16, 0, 0); \
    __builtin_amdgcn_global_load_lds((const unsigned*)(bp + 3 * sb32 + (ko)), l3 + (bufw) + 7168, 16, 0, 0); } while (0)
  const int fr = lane & 15, fq = lane >> 4;
  const int nkt = K >> 6;
  if (!prestaged) {
    __syncthreads();
    STAGE(0, 0);
  }
  for (int kt = 0; kt < nkt; ++kt) {
    asm volatile("s_waitcnt vmcnt(0)" ::: "memory");
    __builtin_amdgcn_s_barrier();
    if (kt + 1 < nkt) STAGE(((kt + 1) & 1) * 8192, (kt + 1) * 64);
    else if (An) {
      ap = An + (size_t)lrow * lda + sch; bp = Btn + (size_t)lrow * ldb + sch;
      STAGE(0, 0);
    }
    const u16* sa = lds + (kt & 1) * 16384;
    const u16* sb = sa + 8192;
#pragma unroll
    for (int ks = 0; ks < 2; ++ks) {
      bf16x8 af[4], bfr[4];
#pragma unroll
      for (int i = 0; i < MI; ++i) af[i] = *(const bf16x8*)(sa + swz(wr * (16 * MI) + i * 16 + fr, ks * 4 + fq));
#pragma unroll
      for (int j = 0; j < 4; ++j) bfr[j] = *(const bf16x8*)(sb + swz(wc * 64 + j * 16 + fr, ks * 4 + fq));
#pragma unroll
      for (int i = 0; i < MI; ++i)
#pragma unroll
        for (int j = 0; j < 4; ++j) acc[i][j] = __builtin_amdgcn_mfma_f32_16x16x32_bf16(bfr[j], af[i], acc[i][j], 0, 0, 0);
    }
  }
#undef STAGE
}
DI int swz32(int row, int chunk) { return row * 32 + ((chunk ^ ((0 - (row >> 2)) & 3)) << 3); }
template <int MI>
DI void gemm_core32(const u16* __restrict__ A, int lda, const u16* __restrict__ Bt, int ldb, int K, f32x4 (&acc)[MI][4], u16* lds, int tid,
                    bool prestaged, const u16* __restrict__ An, const u16* __restrict__ Btn, int& base) {
  constexpr int ABYTES = 32 * MI * 64, SLOT_U32 = (ABYTES + 8192) / 4, SLOT_U16 = (ABYTES + 8192) / 2, P = MI / 2 + 2;
  const int lane = tid & 63, wid = tid >> 6, wr = wid >> 1, wc = wid & 1;
  const int lrow = tid >> 2, lch = tid & 3;
  const int sch = (lch ^ ((0 - (lrow >> 2)) & 3)) * 8;
  const u16* ap = A + (size_t)lrow * lda + sch;
  const u16* bp = Bt + (size_t)lrow * ldb + sch;
  const size_t sa64 = (size_t)64 * lda, sb64 = (size_t)64 * ldb;
  lds_u32* l3 = (lds_u32*)(lds) + tid * 4;
#define STAGE32(slot, pa, pb, ko) do { lds_u32* _l = l3 + (slot) * SLOT_U32; \
    _Pragma("unroll") for (int _i = 0; _i < MI / 2; ++_i) __builtin_amdgcn_global_load_lds((const unsigned*)((pa) + _i * sa64 + (ko)), _l + _i * 1024, 16, 0, 0); \
    __builtin_amdgcn_global_load_lds((const unsigned*)((pb) + (ko)), _l + ABYTES / 4, 16, 0, 0); \
    __builtin_amdgcn_global_load_lds((const unsigned*)((pb) + sb64 + (ko)), _l + ABYTES / 4 + 1024, 16, 0, 0); } while (0)
  const int fr = lane & 15, fq = lane >> 4;
  const int nkt = K >> 5;
  const int aoff = swz32(wr * (16 * MI) + fr, fq), boff = ABYTES / 2 + swz32(wc * 64 + fr, fq);
  if (!prestaged) {
    base = 0;
    __syncthreads();
    STAGE32(0, ap, bp, 0);
    STAGE32(1, ap, bp, 32);
  }
  int slot = base;
  for (int kt = 0; kt < nkt; ++kt) {
    if (kt > 0 && (kt + 1 < nkt || An)) asm volatile("s_waitcnt vmcnt(%0)" :: "n"(P) : "memory");
    else asm volatile("s_waitcnt vmcnt(0)" ::: "memory");
    __builtin_amdgcn_s_barrier();
    const int s2 = (slot == 0) ? 2 : slot - 1;
    if (kt + 2 < nkt) STAGE32(s2, ap, bp, (kt + 2) * 32);
    else if (An) { const u16* apn = An + (size_t)lrow * lda + sch; const u16* bpn = Btn + (size_t)lrow * ldb + sch; STAGE32(s2, apn, bpn, (kt + 2 - nkt) * 32); }
    const u16* sa = lds + slot * SLOT_U16;
    bf16x8 af[MI], bfr[4];
#pragma unroll
    for (int i = 0; i < MI; ++i) af[i] = *(const bf16x8*)(sa + aoff + i * 16 * 32);
#pragma unroll
    for (int j = 0; j < 4; ++j) bfr[j] = *(const bf16x8*)(sa + boff + j * 16 * 32);
#pragma unroll
    for (int i = 0; i < MI; ++i)
#pragma unroll
      for (int j = 0; j < 4; ++j) acc[i][j] = __builtin_amdgcn_mfma_f32_16x16x32_bf16(bfr[j], af[i], acc[i][j], 0, 0, 0);
    slot = (slot == 2) ? 0 : slot + 1;
  }
  base = slot;
#undef STAGE32
}
template <int MI>
DI void zero_acc_n(f32x4 (&acc)[MI][4]) {
#pragma unroll
  for (int i = 0; i < MI; ++i)
#pragma unroll
    for (int j = 0; j < 4; ++j) acc[i][j] = f32x4{0.f, 0.f, 0.f, 0.f};
}
DI void zero_acc(f32x4 (&acc)[4][4]) {
#pragma unroll
  for (int i = 0; i < 4; ++i)
#pragma unroll
    for (int j = 0; j < 4; ++j) acc[i][j] = f32x4{0.f, 0.f, 0.f, 0.f};
}

DI bool sq_tile(int k, int nmt, int nnt, int& mt, int& nt) {
  if (gridDim.x != 512) { const int t = blockIdx.x + k * gridDim.x; mt = t % nmt; nt = t / nmt; return t < nmt * nnt; }
  const int x = blockIdx.x & 7, s = blockIdx.x >> 3, nmg = nmt >> 3;
  const int nst = nmg * ((nnt + 7) >> 3), last = ((nst + 7) >> 3) - 1;
  if (k == last && nst - 8 * last == 4) {
    const int st = k * 8 + (x & 3);
    if (s >= 32) return false;
    mt = (st % nmg) * 8 + (s & 7); nt = (st / nmg) * 8 + (x >> 2) * 4 + (s >> 3);
    return nt < nnt;
  }
  const int st = k * 8 + x;
  mt = (st % nmg) * 8 + (s & 7); nt = (st / nmg) * 8 + (s >> 3);
  return st < nst && nt < nnt;
}
DI int sq_rounds(int nmt, int nnt) { return (gridDim.x != 512) ? (nmt * nnt + gridDim.x - 1) / gridDim.x : ((nmt >> 3) * ((nnt + 7) >> 3) + 7) >> 3; }
DI void epi_put(u16* wl, int row, int j, int fq, unsigned lo, unsigned hi) {
  *(uint2*)(wl + row * 64 + (((j * 2 + (fq >> 1)) ^ (row & 7)) << 3) + (fq & 1) * 4) = make_uint2(lo, hi);
}
template <int MI>
DI void epi_flush(const u16* wl, u16* gbase, size_t ld, int lane) {
#pragma unroll
  for (int p = 0; p < MI * 2; ++p) {
    const int row = p * 8 + (lane >> 3), ch = lane & 7;
    const u32x4 v = *(const u32x4*)(wl + row * 64 + (ch << 3));
    __builtin_nontemporal_store(v, (u32x4*)(gbase + (size_t)row * ld + ((ch ^ (row & 7)) << 3)));
  }
}
DI void step_gemm_in(const Ctx& c, int layer) {
  const int tid = otid(), lane = tid & 63, wid = tid >> 6, wr = wid >> 1, wc = wid & 1, fr = lane & 15, fq = lane >> 4;
  const u16* hb = (const u16*)(c.ws + WS_H);
  const u16* wt = (const u16*)(c.ws + WS_WIN) + (size_t)layer * ZW * 1024;
  u16* zb = (u16*)(c.ws + WS_ZB);
  const float2* rope = (const float2*)(c.ws + WS_ROPE);
  constexpr int MI = 6, CH = 2, BM = 32 * MI, NMT = NTOK / BM, SLOT_U16 = (32 * MI * 64 + 8192) / 2;
  int rbase = 0;
  bool pre = false;
  for (int k = 0, nk = sq_rounds(NMT, 55); k < nk; ++k) {
    int mt, nt; if (!sq_tile(k, NMT, 55, mt, nt)) continue;
    const int m0 = mt * BM, n0 = nt * 128;
    int mtn = 0, ntn2 = 0; const bool hn = (k + 1 < nk) && sq_tile(k + 1, NMT, 55, mtn, ntn2);
    f32x4 acc[MI][4]; zero_acc_n<MI>(acc);
    gemm_core32<MI>(hb + (size_t)m0 * 1024, 1024, wt + (size_t)n0 * 1024, 1024, 1024, acc, (u16*)c.lds, tid, pre,
                    hn ? hb + (size_t)(mtn * BM) * 1024 : nullptr, hn ? wt + (size_t)(ntn2 * 128) * 1024 : nullptr, rbase);
    pre = hn;
    const int nb = n0 + wc * 64, jb = nb >> 6;
    __syncthreads();
    u16* wl = (u16*)c.lds + ((rbase == 0) ? 2 : rbase - 1) * SLOT_U16 + wid * 2048;
    int kind = 0;
    if (jb < 4) kind = 7; else if (jb < 26) kind = 0; else if (jb < 34) kind = 1; else if (jb < 36) kind = 2; else if (jb < 38) kind = 3;
    else if (jb < 46) kind = 4; else if (jb < 54) kind = 5; else if (jb < 62) kind = 6;
    const bool isnorm = (kind == 1 || kind == 2 || kind == 4 || kind == 5);
    const float* gwp = c.in[kind == 1 ? 19 : kind == 2 ? 20 : kind == 4 ? 22 : 23] + layer * 64;
    float4 gwv[4];
    if (isnorm) {
#pragma unroll
      for (int j = 0; j < 4; ++j) gwv[j] = *(const float4*)(gwp + j * 16 + fq * 4);
    }
#pragma unroll
    for (int ps = 0; ps < MI / CH; ++ps) {
#pragma unroll
    for (int ii = 0; ii < CH; ++ii) {
      const int i = ps * CH + ii;
      const int m = m0 + wr * (16 * MI) + i * 16 + fr;
      const bool lat = m >= NCTX;
      float v[4][4];
#pragma unroll
      for (int j = 0; j < 4; ++j)
#pragma unroll
        for (int r = 0; r < 4; ++r) v[j][r] = acc[i][j][r];
      if (isnorm) {
        float ss = 0.f;
#pragma unroll
        for (int j = 0; j < 4; ++j)
#pragma unroll
          for (int r = 0; r < 4; ++r) ss += v[j][r] * v[j][r];
        ss += __shfl_xor(ss, 16); ss += __shfl_xor(ss, 32);
        const float rstd = rsqrtf(ss * (1.f / 64.f) + 1e-6f);
#pragma unroll
        for (int j = 0; j < 4; ++j) {
          const float4 g = gwv[j];
          v[j][0] *= rstd * g.x; v[j][1] *= rstd * g.y; v[j][2] *= rstd * g.z; v[j][3] *= rstd * g.w;
        }
      }
      if (!lat && (kind == 2 || kind == 3 || kind == 5 || kind == 6)) {
        const int b = m >> 8, s = m & 255;
        float* o;
        if (kind == 2) o = c.out + O_SWK + ((size_t)((b * 4 + layer) * 256 + s)) * 128 + (jb - 34) * 64;
        else if (kind == 3) o = c.out + O_SWV + ((size_t)((b * 4 + layer) * 256 + s)) * 128 + (jb - 36) * 64;
        else if (kind == 5) o = c.out + O_NAK + ((size_t)((b * 4 + layer) * 256 + s)) * 512 + (jb - 46) * 64;
        else o = c.out + O_NAV + ((size_t)((b * 4 + layer) * 256 + s)) * 512 + (jb - 54) * 64;
#pragma unroll
        for (int j = 0; j < 4; ++j) *(float4*)(o + j * 16 + fq * 4) = make_float4(v[j][0], v[j][1], v[j][2], v[j][3]);
      }
      if (lat && (kind == 1 || kind == 2)) {
        const int nidx = (m - NCTX) & 1023, prow = nidx >> 6, pcol = nidx & 63;
#pragma unroll
        for (int r = 0; r < 4; ++r) {
          const float2 a = rope[prow * 16 + fq * 4 + r], b2 = rope[pcol * 16 + fq * 4 + r];
          const float x1 = v[0][r], x2 = v[1][r], y1 = v[2][r], y2 = v[3][r];
          v[0][r] = x1 * a.x - x2 * a.y; v[1][r] = x1 * a.y + x2 * a.x;
          v[2][r] = y1 * b2.x - y2 * b2.y; v[3][r] = y1 * b2.y + y2 * b2.x;
        }
      }
      if (kind == 3 || kind == 6) {
        u16* vt = (u16*)(c.ws + (kind == 3 ? WS_VTS : WS_VTN)) + (size_t)((kind == 3 ? jb - 36 : jb - 54) * 64) * NTOK + m;
#pragma unroll
        for (int j = 0; j < 4; ++j)
#pragma unroll
          for (int r = 0; r < 4; ++r) vt[(size_t)(j * 16 + fq * 4 + r) * NTOK] = f2bf(v[j][r]);
      }
      const float sc = (kind == 1 || kind == 4 || kind == 7) ? 0.125f : 1.f;
#pragma unroll
      for (int j = 0; j < 4; ++j) epi_put(wl, ii * 16 + fr, j, fq, pack2(v[j][0] * sc, v[j][1] * sc), pack2(v[j][2] * sc, v[j][3] * sc));
    }
    epi_flush<CH>(wl, zb + (size_t)(m0 + wr * (16 * MI) + ps * CH * 16) * ZW + nb, ZW, lane);
    }
  }
}

DI void step_gemm_merge(const Ctx& c, int layer) {
  const int tid = otid(), lane = tid & 63, wid = tid >> 6, wr = wid >> 1, wc = wid & 1, fr = lane & 15, fq = lane >> 4;
  const u16* att = (const u16*)(c.ws + WS_ATT);
  const u16* zb = (const u16*)(c.ws + WS_ZB);
  u16* mg = (u16*)(c.ws + WS_MRG);
  constexpr int MI = 3, BM = 32 * MI, NMT = NTOK / BM, NT = NMT * 8;
  bool pre = false;
  for (int k = 0, nk = sq_rounds(NMT, 8); k < nk; ++k) {
    int mt, nt; if (!sq_tile(k, NMT, 8, mt, nt)) continue;
    const int m0 = mt * BM, n0 = nt * 128;
    int mtn = 0, ntn2 = 0; const bool hn = (k + 1 < nk) && sq_tile(k + 1, NMT, 8, mtn, ntn2);
    f32x4 acc[4][4]; zero_acc(acc);
#pragma unroll 1
    for (int s = 0; s < 3; ++s) {
      const u16* wp = (const u16*)(c.ws + WS_WP);
      const bool hs = (s < 2) || hn;
      const u16* an = (s < 2) ? att + (size_t)m0 * ATTW + (s + 1) * 512 : att + (size_t)(mtn * BM) * ATTW;
      const u16* bn = (s < 2) ? wp + ((size_t)(layer * 3 + s + 1) * 1024 + n0) * 512 : wp + ((size_t)(layer * 3) * 1024 + ntn2 * 128) * 512;
      uint2 gq[MI][4], gnq[MI][4];
#pragma unroll
      for (int i = 0; i < MI; ++i) {
        const int m = m0 + wr * (16 * MI) + i * 16 + fr;
#pragma unroll
        for (int j = 0; j < 4; ++j) {
          const int n = n0 + wc * 64 + j * 16 + fq * 4;
          gq[i][j] = *(const uint2*)(zb + (size_t)m * ZW + C_GA + s * 1024 + n);
          gnq[i][j] = *(const uint2*)(zb + (size_t)m * ZW + C_GA + (s < 2 ? s + 1 : s) * 1024 + n);
        }
      }
      gemm_core<MI>(att + (size_t)m0 * ATTW + s * 512, ATTW, wp + ((size_t)(layer * 3 + s) * 1024 + n0) * 512, 512, 512, acc, (u16*)c.lds, tid, pre, hs ? an : nullptr, hs ? bn : nullptr);
      pre = hs;
#pragma unroll
      for (int i = 0; i < MI; ++i) {
#pragma unroll
        for (int j = 0; j < 4; ++j) {
          const uint2 g = gq[i][j];
          float f0 = fmaxf(sigmoidf(bflo(g.x)), 1e-6f), f1 = fmaxf(sigmoidf(bfhi(g.x)), 1e-6f), f2 = fmaxf(sigmoidf(bflo(g.y)), 1e-6f), f3 = fmaxf(sigmoidf(bfhi(g.y)), 1e-6f);
          if (s < 2) {
            const uint2 gn = gnq[i][j];
            f0 /= fmaxf(sigmoidf(bflo(gn.x)), 1e-6f); f1 /= fmaxf(sigmoidf(bfhi(gn.x)), 1e-6f); f2 /= fmaxf(sigmoidf(bflo(gn.y)), 1e-6f); f3 /= fmaxf(sigmoidf(bfhi(gn.y)), 1e-6f);
          }
          acc[i][j][0] *= f0; acc[i][j][1] *= f1; acc[i][j][2] *= f2; acc[i][j][3] *= f3;
        }
      }
    }
    __syncthreads();
    u16* wl = (u16*)c.lds + 16384 + wid * 4096;
#pragma unroll
    for (int i = 0; i < MI; ++i)
#pragma unroll
      for (int j = 0; j < 4; ++j) epi_put(wl, i * 16 + fr, j, fq, pack2(acc[i][j][0], acc[i][j][1]), pack2(acc[i][j][2], acc[i][j][3]));
    epi_flush<MI>(wl, mg + (size_t)(m0 + wr * (16 * MI)) * 1024 + n0 + wc * 64, 1024, lane);
  }
}

template <int MODE>
DI void step_gemm_std(const Ctx& c, int layer) {
  const int tid = otid(), lane = tid & 63, wid = tid >> 6, wr = wid >> 1, wc = wid & 1, fr = lane & 15, fq = lane >> 4;
  const u16* A = (const u16*)(c.ws + (MODE == 0 ? WS_MRG : MODE == 1 ? WS_H : WS_U));
  const int lda = (MODE == 2) ? HID : 1024, K = lda;
  const u16* Bt = (const u16*)(c.ws + (MODE == 0 ? WS_WO : MODE == 1 ? WS_W1 : WS_W2)) + (size_t)layer * 1024 * 4096 / (MODE == 0 ? 4 : 1);
  constexpr int ntn = (MODE == 1) ? 32 : 8;
  constexpr int MI = (MODE == 1) ? 6 : 3, CH = 2, BM = 32 * MI, NMT = NTOK / BM, SLOT_U16 = (32 * MI * 64 + 8192) / 2;
  int rbase = 0;
  bool pre = false;
  for (int k = 0, nk = sq_rounds(NMT, ntn); k < nk; ++k) {
    int mt, nt; if (!sq_tile(k, NMT, ntn, mt, nt)) continue;
    const int m0 = mt * BM, n0 = nt * 128;
    int mtn = 0, ntn2 = 0; const bool hn = (k + 1 < nk) && sq_tile(k + 1, NMT, ntn, mtn, ntn2);
    f32x4 acc[MI][4]; zero_acc_n<MI>(acc);
    if (MODE == 1) gemm_core32<MI>(A + (size_t)m0 * lda, lda, Bt + (size_t)n0 * K, K, K, acc, (u16*)c.lds, tid, pre,
                                   hn ? A + (size_t)(mtn * BM) * lda : nullptr, hn ? Bt + (size_t)(ntn2 * 128) * K : nullptr, rbase);
    else gemm_core<3>(A + (size_t)m0 * lda, lda, Bt + (size_t)n0 * K, K, K, (f32x4 (&)[4][4])acc, (u16*)c.lds, tid, pre,
                      hn ? A + (size_t)(mtn * BM) * lda : nullptr, hn ? Bt + (size_t)(ntn2 * 128) * K : nullptr);
    pre = hn;
    u16* wl = (MODE == 1) ? (u16*)c.lds + ((rbase == 0) ? 2 : rbase - 1) * SLOT_U16 + wid * 2048 : (u16*)c.lds + 16384 + wid * 4096;
    if (MODE == 1) __syncthreads();
#pragma unroll
    for (int i = 0; i < MI; ++i) {
      const int m = m0 + wr * (16 * MI) + i * 16 + fr;
      const float* gate = (const float*)(c.ws + WS_MOD) + (layer * 3 + cond_of(m)) * 6144 + (MODE == 0 ? 2048 : 5120);
#pragma unroll
      for (int j = 0; j < 4; ++j) {
        const int n = n0 + wc * 64 + j * 16 + fq * 4;
        if (MODE == 1) {
          float r0 = fmaxf(acc[i][j][0], 0.f), r1 = fmaxf(acc[i][j][1], 0.f), r2 = fmaxf(acc[i][j][2], 0.f), r3 = fmaxf(acc[i][j][3], 0.f);
          epi_put(wl, (i % CH) * 16 + fr, j, fq, pack2(r0 * r0, r1 * r1), pack2(r2 * r2, r3 * r3));
        } else {
          const float* xs = (MODE == 0) ? xrow_src(c, layer, m) : (c.out + (size_t)m * DM);
          const float4 xv = *(const float4*)(xs + n), g = *(const float4*)(gate + n);
          const f32x4 yv = {xv.x + g.x * acc[i][j][0], xv.y + g.y * acc[i][j][1], xv.z + g.z * acc[i][j][2], xv.w + g.w * acc[i][j][3]};
          __builtin_nontemporal_store(yv, (f32x4*)(c.out + (size_t)m * DM + n));
        }
      }
      if (MODE == 1 && (i % CH) == CH - 1) epi_flush<CH>(wl, (u16*)(c.ws + WS_U) + (size_t)(m0 + wr * (16 * MI) + (i / CH) * CH * 16) * HID + n0 + wc * 64, HID, lane);
    }
  }
}

DI int crow(int reg, int h) { return (reg & 3) + 8 * (reg >> 2) + 4 * h; }
DI void attn_item(const Ctx& c, int layer, int kind, int b, int hq, int qb) {
  const int tid = otid(), lane = tid & 63, wid = tid >> 6, ql = lane & 31, hh = lane >> 5;
  u16* Ks0 = (u16*)c.lds;
  float* rpb = (float*)(c.lds + 2 * 17408);
  const u16* zb = (const u16*)(c.ws + WS_ZB);
  u16* att = (u16*)(c.ws + WS_ATT);
  const bool isB = (kind == 0 || kind == 2);
  const int qcol = isB ? C_BQ + hq * 64 : C_CQ + hq * 64;
  const int kcol = isB ? C_BK + (hq >> 2) * 64 : C_CK + hq * 64;
  const int vcol = isB ? C_BV + (hq >> 2) * 64 : C_CV + hq * 64;
  const int outcol = isB ? 512 + hq * 64 : 1024 + hq * 64;
  int qtok0, ntiles, zrow0 = 0, tlo = 0, rs0 = 0;
  const u16 *kc = nullptr, *vc = nullptr;
  const int hk = isB ? (hq >> 2) : hq;
  const u16* vtl = (const u16*)(c.ws + (isB ? WS_VTS : WS_VTN)) + (size_t)(hk * 64) * NTOK;
  if (kind < 2) { qtok0 = b * 256 + qb * 128; ntiles = 4; zrow0 = b * 256; }
  else if (kind == 2) {
    qtok0 = NCTX + b * 1024 + qb * 128;
    tlo = (qb == 0) ? 2 : 0; const int thi = (qb == 7) ? 4 : 6; ntiles = 8 + thi - tlo;
    zrow0 = NCTX + b * 1024 + (qb - 1) * 128 + tlo * 64;
    kc = (const u16*)(c.ws + WS_KCS) + ((size_t)(b * 4 + layer) * 2 + hk) * 512 * 64; vc = (const u16*)(c.ws + WS_VCS) + ((size_t)(b * 4 + layer) * 2 + hk) * 64 * 512;
  } else {
    qtok0 = NCTX + b * 1024 + qb * 128;
    rs0 = min(max(2 * qb - 4, 0), 8); const int rs1 = min(max(2 * qb - 3, 0), 8); ntiles = 8 + rs1 + 8 - rs0;
    zrow0 = NCTX + b * 1024 + rs0 * 64;
    kc = (const u16*)(c.ws + WS_KCN) + ((size_t)(b * 4 + layer) * 8 + hk) * 512 * 64; vc = (const u16*)(c.ws + WS_VCN) + ((size_t)(b * 4 + layer) * 8 + hk) * 64 * 512;
  }
  const int ncache = (kind >= 2) ? 8 : 0;
  bf16x8 qf[4];
  {
    const u16* qp = zb + (size_t)(qtok0 + wid * 32 + ql) * ZW + qcol + hh * 8;
#pragma unroll
    for (int ks = 0; ks < 4; ++ks) qf[ks] = *(const bf16x8*)(qp + ks * 16);
  }
  __syncthreads();
  if (kind == 3) { for (int e = tid; e < 465; e += 256) rpb[e] = c.in[24][(size_t)(layer * 8 + hq) * 465 + e]; }
  float m_run, l_run;
  if (isB) { m_run = c.in[21][layer * 8 + hq]; l_run = (hh == 0) ? 1.f : 0.f; } else { m_run = -1e30f; l_run = 0.f; }
  f32x16 o0, o1;
#pragma unroll
  for (int r = 0; r < 16; ++r) { o0[r] = 0.f; o1[r] = 0.f; }
  const int qpos = qb * 128 + wid * 32 + ql;
  const int qr = 2 * qb + (wid >> 1), qc = (wid & 1) * 32 + ql;
  const int wrs = min(max(qr - 4, 0), 8), ccs = min(max(qc - 8, 0), 48);

  uint4 rk0, rk1, rv0, rv1;
  const int srow = tid >> 3, sc8 = tid & 7;
  auto prefetch = [&](int t) {
    const u16 *kp, *vp; size_t kst, vst;
    if (t < ncache) { kp = kc + (size_t)t * 64 * 64; kst = 64; vp = vc + t * 64; vst = 512; }
    else { const int row0 = zrow0 + (t - ncache) * 64; kp = zb + (size_t)row0 * ZW + kcol; kst = ZW; vp = vtl + row0; vst = NTOK; }
    rk0 = *(const uint4*)(kp + (size_t)srow * kst + sc8 * 8); rk1 = *(const uint4*)(kp + (size_t)(srow + 32) * kst + sc8 * 8);
    rv0 = *(const uint4*)(vp + (size_t)srow * vst + sc8 * 8); rv1 = *(const uint4*)(vp + (size_t)(srow + 32) * vst + sc8 * 8);
  };
  auto stash = [&](int t) {
    u16* Ks = Ks0 + (t & 1) * 8704; u16* Vt = Ks + 4096;
    *(uint4*)(Ks + swz(srow, sc8)) = rk0; *(uint4*)(Ks + swz(srow + 32, sc8)) = rk1;
    *(uint4*)(Vt + srow * 72 + sc8 * 8) = rv0; *(uint4*)(Vt + (srow + 32) * 72 + sc8 * 8) = rv1;
  };

  prefetch(0);
  stash(0);
  if (ntiles > 1) prefetch(1);
  for (int t = 0; t < ntiles; ++t) {
    __syncthreads();
    if (t + 1 < ntiles) { stash(t + 1); if (t + 2 < ntiles) prefetch(t + 2); }
    const u16* Ks = Ks0 + (t & 1) * 8704; const u16* Vt = Ks + 4096;
    bool skip = false;
    int kp0 = 0, kr = 0;
    const bool local = (t >= ncache) && kind >= 2;
    if (local && kind == 2) {
      kp0 = (qb - 1) * 128 + (tlo + t - ncache) * 64;
      const int qlo = qb * 128 + wid * 32;
      skip = (kp0 + 63 < qlo - 128) || (kp0 > qlo + 31 + 128);
    } else if (local && kind == 3) {
      kr = rs0 + (t - ncache);
      skip = (kr < wrs) || (kr >= wrs + 8);
    }
    if (!skip) {
      f32x16 s0, s1;
#pragma unroll
      for (int r = 0; r < 16; ++r) { s0[r] = 0.f; s1[r] = 0.f; }
#pragma unroll
      for (int ks = 0; ks < 4; ++ks) {
        const bf16x8 k0 = *(const bf16x8*)(Ks + swz(ql, ks * 2 + hh));
        const bf16x8 k1 = *(const bf16x8*)(Ks + swz(32 + ql, ks * 2 + hh));
        s0 = __builtin_amdgcn_mfma_f32_32x32x16_bf16(k0, qf[ks], s0, 0, 0, 0);
        s1 = __builtin_amdgcn_mfma_f32_32x32x16_bf16(k1, qf[ks], s1, 0, 0, 0);
      }
      if (local && kind == 2) {
#pragma unroll
        for (int r = 0; r < 16; ++r) {
          const int d0 = kp0 + crow(r, hh) - qpos, d1 = d0 + 32;
          if (d0 < -128 || d0 > 128) s0[r] = -1e30f;
          if (d1 < -128 || d1 > 128) s1[r] = -1e30f;
        }
      } else if (local && kind == 3) {
        const float* rp = rpb + (kr - qr + 7) * 31 + 15 - qc;
#pragma unroll
        for (int r = 0; r < 16; ++r) {
          const int k0c = crow(r, hh), k1c = k0c + 32;
          s0[r] = (k0c >= ccs && k0c < ccs + 16) ? s0[r] + rp[k0c] : -1e30f;
          s1[r] = (k1c >= ccs && k1c < ccs + 16) ? s1[r] + rp[k1c] : -1e30f;
        }
      }
      float mx = s0[0];
#pragma unroll
      for (int r = 1; r < 16; ++r) mx = fmaxf(mx, s0[r]);
#pragma unroll
      for (int r = 0; r < 16; ++r) mx = fmaxf(mx, s1[r]);
      mx = fmaxf(mx, __shfl_xor(mx, 32));
      const float m_new = fmaxf(m_run, mx);
      const float alpha = __expf(m_run - m_new);
      m_run = m_new;
      float rs = 0.f;
#pragma unroll
      for (int r = 0; r < 16; ++r) { s0[r] = __expf(s0[r] - m_new); s1[r] = __expf(s1[r] - m_new); rs += s0[r] + s1[r]; }
      l_run = l_run * alpha + rs;
#pragma unroll
      for (int r = 0; r < 16; ++r) { o0[r] *= alpha; o1[r] *= alpha; }
#pragma unroll
      for (int kt = 0; kt < 2; ++kt) {
#pragma unroll
        for (int s = 0; s < 2; ++s) {
          u32x4 pw;
          if (kt == 0) { pw[0] = pack2(s0[8 * s + 0], s0[8 * s + 1]); pw[1] = pack2(s0[8 * s + 2], s0[8 * s + 3]); pw[2] = pack2(s0[8 * s + 4], s0[8 * s + 5]); pw[3] = pack2(s0[8 * s + 6], s0[8 * s + 7]); }
          else { pw[0] = pack2(s1[8 * s + 0], s1[8 * s + 1]); pw[1] = pack2(s1[8 * s + 2], s1[8 * s + 3]); pw[2] = pack2(s1[8 * s + 4], s1[8 * s + 5]); pw[3] = pack2(s1[8 * s + 6], s1[8 * s + 7]); }
          const bf16x8 pf = __builtin_bit_cast(bf16x8, pw);
          const int ko = kt * 32 + 16 * s + 4 * hh;
          {
            const u32x2 lo = *(const u32x2*)(Vt + ql * 72 + ko), hi = *(const u32x2*)(Vt + ql * 72 + ko + 8);
            u32x4 vw; vw[0] = lo[0]; vw[1] = lo[1]; vw[2] = hi[0]; vw[3] = hi[1];
            o0 = __builtin_amdgcn_mfma_f32_32x32x16_bf16(__builtin_bit_cast(bf16x8, vw), pf, o0, 0, 0, 0);
          }
          {
            const u32x2 lo = *(const u32x2*)(Vt + (32 + ql) * 72 + ko), hi = *(const u32x2*)(Vt + (32 + ql) * 72 + ko + 8);
            u32x4 vw; vw[0] = lo[0]; vw[1] = lo[1]; vw[2] = hi[0]; vw[3] = hi[1];
            o1 = __builtin_amdgcn_mfma_f32_32x32x16_bf16(__builtin_bit_cast(bf16x8, vw), pf, o1, 0, 0, 0);
          }
        }
      }
    }
  }
  const float lt = l_run + __shfl_xor(l_run, 32);
  const float inv = 1.f / lt;
  u16* op = att + (size_t)(qtok0 + wid * 32 + ql) * ATTW + outcol + 4 * hh;
#pragma unroll
  for (int g = 0; g < 4; ++g) {
    *(uint2*)(op + 8 * g) = make_uint2(pack2(o0[4 * g] * inv, o0[4 * g + 1] * inv), pack2(o0[4 * g + 2] * inv, o0[4 * g + 3] * inv));
    *(uint2*)(op + 32 + 8 * g) = make_uint2(pack2(o1[4 * g] * inv, o1[4 * g + 1] * inv), pack2(o1[4 * g + 2] * inv, o1[4 * g + 3] * inv));
  }
}

DI void gla_g1_item(const Ctx& c, int layer, int cu, int h, int dir) {
  const int tid = otid(), lane = tid & 63, wid = tid >> 6, ql = lane & 31, hh = lane >> 5;
  u16* Qs = (u16*)c.lds;
  u16* KPs = Qs + 2048;
  u16* KPT = KPs + 2048;
  u16* VT = KPT + 64 * 40;
  float* al = (float*)(VT + 128 * 40);
  float* tot = al + 512;
  const u16* zb = (const u16*)(c.ws + WS_ZB);
  const int tok0 = cu * 32, idx = (cu * 4 + h) * 2 + dir;
  const int d = lane, part = wid;
  __syncthreads();
  if (tid < 128) {
    const int i = tid >> 2, c4 = tid & 3, tok = tok0 + (dir ? 31 - i : i);
    const uint2 av = *(const uint2*)(zb + (size_t)tok * ZW + C_ALF + dir * 16 + c4 * 4);
    *(float4*)(al + i * 16 + c4 * 4) = make_float4(bflo(av.x), bfhi(av.x), bflo(av.y), bfhi(av.y));
  }
  float qv[8], kv[8];
#pragma unroll
  for (int ii = 0; ii < 8; ++ii) {
    const int i = part * 8 + ii, tok = tok0 + (dir ? 31 - i : i);
    qv[ii] = bf2f(zb[(size_t)tok * ZW + C_AQ + h * 64 + d]);
    kv[ii] = bf2f(zb[(size_t)tok * ZW + C_AK + h * 64 + d]);
  }
  uint4 vr0, vr1;
  {
    const int q0 = tid, q1 = tid + 256;
    const int i0 = q0 >> 4, i1 = q1 >> 4;
    vr0 = *(const uint4*)(zb + (size_t)(tok0 + (dir ? 31 - i0 : i0)) * ZW + C_AV + h * 128 + (q0 & 15) * 8);
    vr1 = *(const uint4*)(zb + (size_t)(tok0 + (dir ? 31 - i1 : i1)) * ZW + C_AV + h * 128 + (q1 & 15) * 8);
  }
  float w2[16];
  {
    const float* wp = c.in[dir ? 16 : 14] + (size_t)layer * 16 * 256 + h * 64 + d;
#pragma unroll
    for (int r = 0; r < 16; ++r) w2[r] = wp[r * 256];
  }
  const float b2 = c.in[dir ? 17 : 15][layer * 256 + h * 64 + d];
  __syncthreads();
  float cl[8];
  {
    float run = 0.f;
#pragma unroll
    for (int ii = 0; ii < 8; ++ii) {
      const int i = part * 8 + ii;
      float x = b2;
#pragma unroll
      for (int r4 = 0; r4 < 4; ++r4) {
        const float4 a4 = *(const float4*)(al + i * 16 + r4 * 4);
        x += a4.x * w2[r4 * 4] + a4.y * w2[r4 * 4 + 1] + a4.z * w2[r4 * 4 + 2] + a4.w * w2[r4 * 4 + 3];
      }
      const float ls = fminf(x, 0.f) - __logf(1.f + __expf(-fabsf(x)));
      run += ls * (1.f / 16.f);
      cl[ii] = run;
    }
    tot[part * 64 + d] = run;
  }
  {
    const int i0 = tid >> 4, c0 = (tid & 15) * 8, i1 = (tid + 256) >> 4;
    const unsigned w0[4] = {vr0.x, vr0.y, vr0.z, vr0.w}, w1[4] = {vr1.x, vr1.y, vr1.z, vr1.w};
#pragma unroll
    for (int e = 0; e < 4; ++e) {
      VT[(c0 + 2 * e) * 40 + i0] = (u16)(w0[e] & 0xffffu); VT[(c0 + 2 * e + 1) * 40 + i0] = (u16)(w0[e] >> 16);
      VT[(c0 + 2 * e) * 40 + i1] = (u16)(w1[e] & 0xffffu); VT[(c0 + 2 * e + 1) * 40 + i1] = (u16)(w1[e] >> 16);
    }
  }
  __syncthreads();
  {
    float off = 0.f;
    if (part > 0) off += tot[d];
    if (part > 1) off += tot[64 + d];
    if (part > 2) off += tot[128 + d];
    u16* qg = (u16*)(c.ws + WS_QIN) + (size_t)idx * 2048;
#pragma unroll
    for (int ii = 0; ii < 8; ++ii) {
      const int i = part * 8 + ii;
      const float ex = __expf(cl[ii] + off);
      const u16 qi = f2bf(qv[ii] * ex), kp = f2bf(kv[ii] / ex);
      Qs[swz(i, d >> 3) + (d & 7)] = qi; KPs[swz(i, d >> 3) + (d & 7)] = kp; KPT[d * 40 + i] = kp;
      qg[(dir ? 31 - i : i) * 64 + d] = qi;
    }
    if (part == 0) ((float*)(c.ws + WS_AV))[(size_t)idx * 64 + d] = __expf(tot[d] + tot[64 + d] + tot[128 + d] + tot[192 + d]);
  }
  __syncthreads();
  f32x16 at;
#pragma unroll
  for (int r = 0; r < 16; ++r) at[r] = 0.f;
#pragma unroll
  for (int ks = 0; ks < 4; ++ks) {
    const bf16x8 a = *(const bf16x8*)(KPs + swz(ql, ks * 2 + hh));
    const bf16x8 b = *(const bf16x8*)(Qs + swz(ql, ks * 2 + hh));
    at = __builtin_amdgcn_mfma_f32_32x32x16_bf16(a, b, at, 0, 0, 0);
  }
#pragma unroll
  for (int r = 0; r < 16; ++r) if (crow(r, hh) > ql) at[r] = 0.f;
  f32x16 oi;
#pragma unroll
  for (int r = 0; r < 16; ++r) oi[r] = 0.f;
#pragma unroll
  for (int s = 0; s < 2; ++s) {
    u32x4 pw; pw[0] = pack2(at[8 * s + 0], at[8 * s + 1]); pw[1] = pack2(at[8 * s + 2], at[8 * s + 3]); pw[2] = pack2(at[8 * s + 4], at[8 * s + 5]); pw[3] = pack2(at[8 * s + 6], at[8 * s + 7]);
    const int ko = 16 * s + 4 * hh;
    const u32x2 lo = *(const u32x2*)(VT + (wid * 32 + ql) * 40 + ko), hi = *(const u32x2*)(VT + (wid * 32 + ql) * 40 + ko + 8);
    u32x4 vw; vw[0] = lo[0]; vw[1] = lo[1]; vw[2] = hi[0]; vw[3] = hi[1];
    oi = __builtin_amdgcn_mfma_f32_32x32x16_bf16(__builtin_bit_cast(bf16x8, vw), __builtin_bit_cast(bf16x8, pw), oi, 0, 0, 0);
  }
  {
    u16* ob = (u16*)(c.ws + (dir ? WS_OB : WS_OF)) + (size_t)(tok0 + (dir ? 31 - ql : ql)) * 512 + h * 128 + wid * 32 + 4 * hh;
#pragma unroll
    for (int g = 0; g < 4; ++g) *(uint2*)(ob + 8 * g) = make_uint2(pack2(oi[4 * g], oi[4 * g + 1]), pack2(oi[4 * g + 2], oi[4 * g + 3]));
  }
  u16* dsp = (u16*)(c.ws + WS_DS) + (size_t)idx * 8192;
  f32x16 dacc[2];
#pragma unroll
  for (int dt = 0; dt < 2; ++dt) {
#pragma unroll
    for (int r = 0; r < 16; ++r) dacc[dt][r] = 0.f;
#pragma unroll
    for (int ks = 0; ks < 2; ++ks) {
      const bf16x8 a = *(const bf16x8*)(VT + (wid * 32 + ql) * 40 + ks * 16 + 8 * hh);
      const bf16x8 b = *(const bf16x8*)(KPT + (dt * 32 + ql) * 40 + ks * 16 + 8 * hh);
      dacc[dt] = __builtin_amdgcn_mfma_f32_32x32x16_bf16(a, b, dacc[dt], 0, 0, 0);
    }
  }
  __syncthreads();
  u16* img = (u16*)c.lds + wid * 2048;
#pragma unroll
  for (int dt = 0; dt < 2; ++dt)
#pragma unroll
    for (int r = 0; r < 16; ++r) img[crow(r, hh) * 64 + dt * 32 + ql] = f2bf(dacc[dt][r]);
#pragma unroll
  for (int p = 0; p < 4; ++p) {
    const int row = p * 8 + (lane >> 3), ch = lane & 7;
    *(uint4*)(dsp + (size_t)(wid * 32 + row) * 64 + ch * 8) = *(const uint4*)(img + row * 64 + ch * 8);
  }
}

DI void step_mixers(const Ctx& c, int layer) {
  unsigned* ctr = (unsigned*)(c.ws + WS_CTR) + layer * 64;
  volatile int* slot = (volatile int*)(c.lds + LDS_BYTES);
  constexpr int TOTAL = 128 + 128 + 1536 + 256 + 256;
  bool first = true;
  for (;;) {
    int idx;
    if (first) { idx = (int)blockIdx.x; first = false; }
    else {
      __syncthreads();
      if (otid() == 0) *slot = (int)(atomicAdd(ctr, 1u) + gridDim.x);
      __syncthreads();
      idx = *slot;
    }
    if (idx >= TOTAL) break;
    int isg, a0, a1, a2, a3;
    if (idx < 128) { const int j = idx; isg = 0; a0 = 3; a1 = j >> 6; a2 = (j >> 3) & 7; a3 = j & 7; }
    else if (idx < 256) { const int j = idx - 128; isg = 0; a0 = 2; a1 = j >> 6; a2 = (j >> 3) & 7; a3 = j & 7; }
    else if (idx < 512) { const int j = idx - 256; isg = 0; a0 = 0; a1 = j >> 4; a2 = (j >> 1) & 7; a3 = j & 1; }
    else if (idx < 768) { const int j = idx - 512; isg = 0; a0 = 1; a1 = j >> 4; a2 = (j >> 1) & 7; a3 = j & 1; }
    else { const int j = idx - 768; isg = 1; a0 = j >> 3; a1 = (j >> 1) & 3; a2 = j & 1; a3 = 0; }
    if (isg) gla_g1_item(c, layer, a0, a1, a2); else attn_item(c, layer, a0, a1, a2, a3);
  }
}

DI void step_gla_scan(const Ctx& c, int layer) {
  const int tid = otid(), v16 = tid >> 4, dq = tid & 15;
  const u16* dS = (const u16*)(c.ws + WS_DS);
  const float* av = (const float*)(c.ws + WS_AV);
  u16* Sb = (u16*)(c.ws + WS_SB);
  for (int it = blockIdx.x; it < 1152; it += gridDim.x) {
    const int u = it >> 3, vb = it & 7, seq = u >> 3, h = (u >> 1) & 3, dir = u & 1, v = vb * 16 + v16;
    const int nch = seq < 16 ? 8 : 32, cu0 = seq < 16 ? seq * 8 : 128 + (seq - 16) * 32;
    float4 S = make_float4(0.f, 0.f, 0.f, 0.f);
    if (seq >= 16) {
      const float* sp = c.in[2] + ((((size_t)(seq - 16) * 4 + layer) * 2 + dir) * 4 + h) * 8192 + (size_t)(dq * 4) * 128 + v;
      S = make_float4(sp[0], sp[128], sp[256], sp[384]);
    }
#pragma unroll 8
    for (int cc = 0; cc < nch; ++cc) {
      const int cu = cu0 + (dir ? nch - 1 - cc : cc);
      const size_t idx = (size_t)((cu * 4 + h) * 2 + dir);
      *(uint2*)(Sb + idx * 8192 + v * 64 + dq * 4) = make_uint2(pack2(S.x, S.y), pack2(S.z, S.w));
      const uint2 dsr = *(const uint2*)(dS + idx * 8192 + v * 64 + dq * 4);
      const float4 ds = make_float4(bflo(dsr.x), bfhi(dsr.x), bflo(dsr.y), bfhi(dsr.y)), a = *(const float4*)(av + idx * 64 + dq * 4);
      S.x = a.x * (S.x + ds.x); S.y = a.y * (S.y + ds.y); S.z = a.z * (S.z + ds.z); S.w = a.w * (S.w + ds.w);
    }
    if (seq < 16) {
      float* sp = c.out + O_ST + ((((size_t)seq * 4 + layer) * 2 + dir) * 4 + h) * 8192 + (size_t)(dq * 4) * 128 + v;
      sp[0] = S.x; sp[128] = S.y; sp[256] = S.z; sp[384] = S.w;
    }
  }
}

DI void step_gla_out(const Ctx& c, int layer) {
  const int tid = otid(), lane = tid & 63, wid = tid >> 6, ql = lane & 31, hh = lane >> 5;
  const u16* Sb = (const u16*)(c.ws + WS_SB);
  const u16* qin = (const u16*)(c.ws + WS_QIN);
  const u16* of = (const u16*)(c.ws + WS_OF); const u16* ob = (const u16*)(c.ws + WS_OB);
  const u16* zb = (const u16*)(c.ws + WS_ZB);
  u16* att = (u16*)(c.ws + WS_ATT);
  float* red = (float*)c.lds;
  for (int it = blockIdx.x; it < 768; it += gridDim.x) {
    const int cu = it >> 2, h = it & 3, tok = cu * 32 + ql, vt = wid;
    f32x16 acc;
#pragma unroll
    for (int r = 0; r < 16; ++r) acc[r] = 0.f;
#pragma unroll
    for (int dir = 0; dir < 2; ++dir) {
      const size_t idx = (size_t)((cu * 4 + h) * 2 + dir);
#pragma unroll
      for (int ks = 0; ks < 4; ++ks) {
        const bf16x8 q = *(const bf16x8*)(qin + idx * 2048 + ql * 64 + ks * 16 + hh * 8);
        const bf16x8 a = *(const bf16x8*)(Sb + idx * 8192 + (vt * 32 + ql) * 64 + ks * 16 + hh * 8);
        acc = __builtin_amdgcn_mfma_f32_32x32x16_bf16(a, q, acc, 0, 0, 0);
      }
    }
    float ss = 0.f;
#pragma unroll
    for (int g = 0; g < 4; ++g) {
      const size_t o = (size_t)tok * 512 + h * 128 + vt * 32 + 8 * g + 4 * hh;
      const uint2 a = *(const uint2*)(of + o), b = *(const uint2*)(ob + o);
      acc[4 * g] += bflo(a.x) + bflo(b.x); acc[4 * g + 1] += bfhi(a.x) + bfhi(b.x); acc[4 * g + 2] += bflo(a.y) + bflo(b.y); acc[4 * g + 3] += bfhi(a.y) + bfhi(b.y);
      ss += acc[4 * g] * acc[4 * g] + acc[4 * g + 1] * acc[4 * g + 1] + acc[4 * g + 2] * acc[4 * g + 2] + acc[4 * g + 3] * acc[4 * g + 3];
    }
    ss += __shfl_xor(ss, 32);
    float4 gnq[4]; uint2 arq[4];
#pragma unroll
    for (int g = 0; g < 4; ++g) {
      const int v = vt * 32 + 8 * g + 4 * hh;
      gnq[g] = *(const float4*)(c.in[18] + layer * 128 + v);
      arq[g] = *(const uint2*)(zb + (size_t)tok * ZW + C_AR + h * 128 + v);
    }
    __syncthreads();
    if (hh == 0) red[wid * 32 + ql] = ss;
    __syncthreads();
    const float tot = red[ql] + red[32 + ql] + red[64 + ql] + red[96 + ql];
    const float rstd = rsqrtf(tot * (1.f / 128.f) + 1e-6f);
#pragma unroll
    for (int g = 0; g < 4; ++g) {
      const int v = vt * 32 + 8 * g + 4 * hh;
      const float4 gn = gnq[g];
      const uint2 ar = arq[g];
      const float y0 = acc[4 * g] * rstd * gn.x * siluf(bflo(ar.x)), y1 = acc[4 * g + 1] * rstd * gn.y * siluf(bfhi(ar.x));
      const float y2 = acc[4 * g + 2] * rstd * gn.z * siluf(bflo(ar.y)), y3 = acc[4 * g + 3] * rstd * gn.w * siluf(bfhi(ar.y));
      *(uint2*)(att + (size_t)tok * ATTW + h * 128 + v) = make_uint2(pack2(y0, y1), pack2(y2, y3));
    }
  }
}

__global__ void __launch_bounds__(256, 2) trunk_fwd(Params p) {
  __shared__ __attribute__((aligned(16))) unsigned char lds[LDS_BYTES + 32];
  volatile unsigned* st = (volatile unsigned*)(lds + LDS_BYTES + 16);
  unsigned* bar = (unsigned*)(p.ws + WS_BAR);
  unsigned xcc = 0;
  if (p.one) {
    if (threadIdx.x == 0) { st[0] = 0u; st[1] = 0u; }
    __syncthreads();
    xcc = xb_xcc_id();
    if (threadIdx.x == 0) (void)xb_add(&bar[XB_XCNT(xcc)], 1u);
  }
  for (int step0 = p.ph_lo; step0 < p.ph_hi; ++step0) {
    int step = step0; asm volatile("" : "+s"(step));
    Ctx c; c.in = p.in; c.out = p.out; c.ws = p.ws; c.lds = lds;
    if (step == 0) step_prep(c);
    else {
      const int layer = (step - 1) / NSPL, sub = (step - 1) % NSPL;
      switch (sub) {
        case 0: step_norm(c, layer, 0); break;
        case 1: step_gemm_in(c, layer); break;
        case 2: step_mixers(c, layer); break;
        case 3: step_gla_scan(c, layer); break;
        case 4: step_gla_out(c, layer); break;
        case 5: step_gemm_merge(c, layer); break;
        case 6: step_gemm_std<0>(c, layer); break;
        case 7: step_norm(c, layer, 1); break;
        case 8: step_gemm_std<1>(c, layer); break;
        default: step_gemm_std<2>(c, layer); break;
      }
    }
    if (step0 + 1 < p.ph_hi) {
      if (p.one == 2) cg::this_grid().sync();
      else xcd_barrier(bar, xcc, st);
    }
  }
}

extern "C" void kernel_launch(void* const* d_in, const int* in_sizes, int n_in, void* d_out, int out_size, void* d_ws, size_t ws_size, hipStream_t stream) {
  static int grid = 0;
  if (grid == 0) {
    if (n_in != 31 || ws_size < WS_END) { fprintf(stderr, "kernel_launch: unexpected n_in %d or ws_size %zu (< %zu)\n", n_in, ws_size, (size_t)WS_END); grid = -1; return; }
    int dev = 0, cus = 0, per_cu = 0;
    hipGetDevice(&dev);
    hipDeviceGetAttribute(&cus, hipDeviceAttributeMultiprocessorCount, dev);
    hipOccupancyMaxActiveBlocksPerMultiprocessor(&per_cu, (const void*)trunk_fwd, 256, 0);
    if (per_cu < 1) per_cu = 1;
    if (per_cu > 2) per_cu = 2;
    grid = cus * per_cu;
  }
  if (grid < 0) return;
  hipMemsetAsync((char*)d_ws + WS_BAR, 0, 65536, stream);
  Params p{};
  for (int i = 0; i < 31; ++i) p.in[i] = (const float*)d_in[i];
  p.out = (float*)d_out; p.ws = (unsigned char*)d_ws;
#if MK_ONE_LAUNCH
  p.ph_lo = 0; p.ph_hi = NSTEPS; p.one = 1;
  void* args[] = {&p};
  hipError_t e = hipLaunchCooperativeKernel((const void*)trunk_fwd, dim3(grid), dim3(256), args, 0, stream);
  if (e != hipSuccess) fprintf(stderr, "cooperative launch failed: %s (grid %d)\n", hipGetErrorString(e), grid);
#else
  for (int s = 0; s < NSTEPS; ++s) {
    p.ph_lo = s; p.ph_hi = s + 1; p.one = 0;
    hipLaunchKernelGGL(trunk_fwd, dim3(grid), dim3(256), 0, stream, p);
  }
#endif
}
```
